# Optimizing an MI355X kernel written in HIP

```python
import math
import jax, jax.numpy as jnp
from jax import lax
import numpy as np

D_MODEL = 1024
BATCH = 8
SEQ = 4096
DEPTH = 1
DEC_BATCH = 128
DEC_SEQ = 1
PAST_LEN = 8192
PAGE_SIZE = 128

MIX_WIDTH = 2 * D_MODEL
SSD_WIDTH = MIX_WIDTH // 2
SSD_HEAD_DIM = 64
SSD_HEADS = SSD_WIDTH // SSD_HEAD_DIM
SSD_GROUPS = 4
SSD_HEADS_PER_GROUP = SSD_HEADS // SSD_GROUPS
SSD_STATE = 128
SSD_CHUNK = 128
CONV_W = 4
CONV_DIM = SSD_WIDTH + 2 * SSD_GROUPS * SSD_STATE
ATT_WIDTH = MIX_WIDTH // 4
ATT_HEAD_DIM = 64
ATT_HEADS = ATT_WIDTH // ATT_HEAD_DIM
DILATED_PAIRS = ((128, 1), (512, 4), (2048, 16))
MAX_WINDOW = 2048
ATT_BLOCK = 128
ROPE_THETA = 500000.0
ROPE_DIM = ATT_HEAD_DIM // 4
MEM_LEN = 256
CROSS_WIDTH = MIX_WIDTH // 4
CROSS_HEADS = 4
CROSS_HEAD_DIM = CROSS_WIDTH // CROSS_HEADS
NORM_EPS = 1e-6
N_IN = 2 * SSD_WIDTH + 2 * SSD_GROUPS * SSD_STATE + SSD_HEADS + 4 * ATT_WIDTH + 2 * CROSS_WIDTH

kernel_name = 'hymba_ssd_dilated_swa_memxattn_step'

F32 = jnp.float32


def rms_norm(x, g):
    x32 = x.astype(F32)
    y = x32 * lax.rsqrt(jnp.mean(x32 * x32, axis=-1, keepdims=True) + NORM_EPS)
    return (y * g.astype(F32)).astype(x.dtype)


def split_projection(u):
    sizes = (SSD_WIDTH, CONV_DIM, SSD_HEADS, ATT_WIDTH, ATT_WIDTH, ATT_WIDTH, ATT_WIDTH, CROSS_WIDTH, CROSS_WIDTH)
    idx = np.cumsum(sizes)[:-1].tolist()
    return jnp.split(u, idx, axis=-1)


def heads(a, n):
    return a.reshape(a.shape[:-1] + (n, a.shape[-1] // n))


def rotary(x, pos):
    half = ROPE_DIM // 2
    inv = ROPE_THETA ** (-jnp.arange(half, dtype=F32) / half)
    ang = pos.astype(F32)[..., None] * inv
    cos = jnp.cos(ang)[..., None, :]
    sin = jnp.sin(ang)[..., None, :]
    xr = x[..., :ROPE_DIM].astype(F32)
    x1, x2 = xr[..., :half], xr[..., half:]
    rot = jnp.concatenate([x1 * cos - x2 * sin, x2 * cos + x1 * sin], axis=-1)
    return jnp.concatenate([rot.astype(x.dtype), x[..., ROPE_DIM:]], axis=-1)


def causal_conv(xbc, buf, w, b):
    t = xbc.shape[1]
    xp = jnp.concatenate([buf.astype(xbc.dtype), xbc], axis=1)
    xp32 = xp.astype(F32)
    w32 = w.astype(F32)
    y = b.astype(F32)
    for tap in range(CONV_W):
        y = y + xp32[:, tap:tap + t] * w32[tap]
    return jax.nn.silu(y), xp[:, xp.shape[1] - (CONV_W - 1):]


def ssd_split(xbc_c):
    bsz, t = xbc_c.shape[:2]
    gn = SSD_GROUPS * SSD_STATE
    xs = xbc_c[..., :SSD_WIDTH].reshape(bsz, t, SSD_HEADS, SSD_HEAD_DIM)
    bm = xbc_c[..., SSD_WIDTH:SSD_WIDTH + gn].reshape(bsz, t, SSD_GROUPS, SSD_STATE)
    cm = xbc_c[..., SSD_WIDTH + gn:].reshape(bsz, t, SSD_GROUPS, SSD_STATE)
    return xs, bm, cm


def segsum(a):
    n = a.shape[-1]
    cs = jnp.cumsum(a, axis=-1)
    diff = cs[..., :, None] - cs[..., None, :]
    mask = jnp.tril(jnp.ones((n, n), dtype=bool))
    return jnp.where(mask, diff, -jnp.inf)


def ssd_chunked(x, dt, a, bm, cm, d_skip):
    bsz, s = x.shape[:2]
    nc, L = s // SSD_CHUNK, SSD_CHUNK
    G, R, P, N = SSD_GROUPS, SSD_HEADS_PER_GROUP, SSD_HEAD_DIM, SSD_STATE
    xc = (x * dt[..., None]).reshape(bsz, nc, L, G, R, P)
    adt = (dt * a).reshape(bsz, nc, L, G, R).transpose(0, 3, 4, 1, 2)
    bc = bm.reshape(bsz, nc, L, G, N)
    cc = cm.reshape(bsz, nc, L, G, N)
    a_cs = jnp.cumsum(adt, axis=-1)
    decay = jnp.exp(segsum(adt))
    cb = jnp.einsum('bclgn,bcsgn->bcgls', cc, bc)
    y_diag = jnp.einsum('bcgls,bgrcls,bcsgrp->bclgrp', cb, decay, xc)
    decay_states = jnp.exp(a_cs[..., -1:] - a_cs)
    states = jnp.einsum('bclgn,bgrcl,bclgrp->bcgrpn', bc, decay_states, xc)
    init = jnp.zeros((bsz, 1, G, R, P, N), F32)
    states = jnp.concatenate([init, states], axis=1)
    chunk_decay = jnp.exp(segsum(jnp.pad(a_cs[..., -1], ((0, 0), (0, 0), (0, 0), (1, 0)))))
    new_states = jnp.einsum('bgrzc,bcgrpn->bzgrpn', chunk_decay, states)
    states, final = new_states[:, :-1], new_states[:, -1]
    y_off = jnp.einsum('bclgn,bcgrpn,bgrcl->bclgrp', cc, states, jnp.exp(a_cs))
    y = (y_diag + y_off).reshape(bsz, s, SSD_HEADS, P) + x * d_skip[:, None]
    return y, final.reshape(bsz, SSD_HEADS, P, N)


def ssd_recurrent(x, dt, a, bm, cm, d_skip, h0):
    bsz, t = x.shape[:2]
    G, R, P, N = SSD_GROUPS, SSD_HEADS_PER_GROUP, SSD_HEAD_DIM, SSD_STATE
    xg = x.reshape(bsz, t, G, R, P)
    dtg = dt.reshape(bsz, t, G, R)
    ag = a.reshape(G, R)

    def step(h, inp):
        x_t, dt_t, b_t, c_t = inp
        h = h * jnp.exp(dt_t * ag)[..., None, None] + jnp.einsum('bgrp,bgn->bgrpn', x_t * dt_t[..., None], b_t)
        return h, jnp.einsum('bgrpn,bgn->bgrp', h, c_t)

    h, ys = lax.scan(step, h0.astype(F32).reshape(bsz, G, R, P, N),
                     (xg.swapaxes(0, 1), dtg.swapaxes(0, 1), bm.swapaxes(0, 1), cm.swapaxes(0, 1)))
    y = ys.swapaxes(0, 1).reshape(bsz, t, SSD_HEADS, P) + x * d_skip[:, None]
    return y, h.reshape(bsz, SSD_HEADS, P, N)


def combine_dilations(parts):
    m_all = parts[0][0]
    for m, _, _ in parts[1:]:
        m_all = jnp.maximum(m_all, m)
    num = 0.0
    den = 0.0
    for m, l, acc in parts:
        wgt = jnp.exp(m - m_all)
        num = num + wgt[..., None] * acc
        den = den + wgt * l
    return num / den[..., None]


def dilated_prompt(q, k, v):
    bsz, s, nh, e = q.shape
    scale = e ** -0.5
    parts = []
    for window, dil in DILATED_PAIRS:
        nw = window // dil
        L = s // dil
        nb = -(-L // ATT_BLOCK)
        lp = nb * ATT_BLOCK

        def sub(arr):
            arr = arr.reshape(bsz, L, dil, nh, e)
            return jnp.pad(arr, ((0, 0), (0, lp - L), (0, 0), (0, 0), (0, 0)))

        def kblocks(arr):
            arr = jnp.pad(sub(arr), ((0, 0), (ATT_BLOCK, 0), (0, 0), (0, 0), (0, 0)))
            arr = arr.reshape(bsz, nb + 1, ATT_BLOCK, dil, nh, e)
            return jnp.concatenate([arr[:, :-1], arr[:, 1:]], axis=2)

        qb = sub(q).reshape(bsz, nb, ATT_BLOCK, dil, nh, e)
        kb, vb = kblocks(k), kblocks(v)
        sc = jnp.einsum('bnqrhe,bnkrhe->bnrhqk', qb, kb) * scale
        qi = jnp.arange(ATT_BLOCK)[:, None]
        ki = jnp.arange(2 * ATT_BLOCK)[None, :]
        off = qi + ATT_BLOCK - ki
        key_sub = jnp.arange(nb)[:, None, None] * ATT_BLOCK - ATT_BLOCK + ki[None]
        valid = ((off >= 0) & (off <= nw))[None] & (key_sub >= 0)
        sc = jnp.where(valid[None, :, None, None], sc, -jnp.inf)
        m = jnp.max(sc, axis=-1)
        p = jnp.exp(sc - m[..., None])
        l = jnp.sum(p, axis=-1)
        acc = jnp.einsum('bnrhqk,bnkrhe->bnqrhe', p, vb)
        acc = acc.reshape(bsz, lp, dil, nh, e)[:, :L].reshape(bsz, s, nh, e)

        def back(arr):
            return arr.transpose(0, 1, 4, 2, 3).reshape(bsz, lp, dil, nh)[:, :L].reshape(bsz, s, nh)

        parts.append((back(m), back(l), acc))
    return combine_dilations(parts)


def dilated_sample(q, k_all, v_all, n_past):
    t = q.shape[1]
    scale = q.shape[-1] ** -0.5
    parts = []
    for window, dil in DILATED_PAIRS:
        nw = window // dil
        idx = n_past + jnp.arange(t)[:, None] - dil * jnp.arange(nw + 1)[None, :]
        valid = idx >= 0
        idx = jnp.maximum(idx, 0)
        kg = k_all[:, idx]
        vg = v_all[:, idx]
        sc = jnp.einsum('bthe,btjhe->bthj', q, kg) * scale
        sc = jnp.where(valid[None, :, None, :], sc, -jnp.inf)
        m = jnp.max(sc, axis=-1)
        p = jnp.exp(sc - m[..., None])
        l = jnp.sum(p, axis=-1)
        acc = jnp.einsum('bthj,btjhe->bthe', p, vg)
        parts.append((m, l, acc))
    return combine_dilations(parts)


def memory_kv(mem, mem_norm_g, w_mem_kv):
    m = rms_norm(mem, mem_norm_g)
    kv = jnp.einsum('bmd,dn->bmn', m, w_mem_kv)
    k, v = jnp.split(kv, 2, axis=-1)
    return heads(k, CROSS_HEADS), heads(v, CROSS_HEADS)


def cross_attend(q, k, v):
    scale = q.shape[-1] ** -0.5
    sc = jnp.einsum('bthe,bmhe->bhtm', q.astype(F32), k.astype(F32)) * scale
    p = jax.nn.softmax(sc, axis=-1)
    return jnp.einsum('bhtm,bmhe->bthe', p, v.astype(F32))


def mix_output(y_ssd, z, o_att, g_att, o_cross, g_cross, ssd_norm_g, w_out, dtype):
    bsz, t = z.shape[:2]
    y = y_ssd.reshape(bsz, t, SSD_WIDTH) * jax.nn.silu(z.astype(F32))
    yg = y.reshape(bsz, t, SSD_GROUPS, SSD_WIDTH // SSD_GROUPS)
    yg = yg * lax.rsqrt(jnp.mean(yg * yg, axis=-1, keepdims=True) + NORM_EPS)
    y = yg.reshape(bsz, t, SSD_WIDTH) * ssd_norm_g.astype(F32)
    att = o_att.reshape(bsz, t, ATT_WIDTH) * jax.nn.silu(g_att.astype(F32))
    crs = o_cross.reshape(bsz, t, CROSS_WIDTH) * jax.nn.silu(g_cross.astype(F32))
    cat = jnp.concatenate([y, att, crs], axis=-1).astype(dtype)
    return jnp.einsum('btn,nd->btd', cat, w_out)


def ssd_params(dt_raw, dt_bias, a_log):
    dt = jax.nn.softplus(dt_raw.astype(F32) + dt_bias.astype(F32))
    a = -jnp.exp(a_log.astype(F32))
    return dt, a


def layer_prompt(x, mem, ln_g, w_in, conv_w, conv_b, dt_bias, a_log, d_skip, ssd_norm_g, mem_norm_g, w_mem_kv, w_out):
    bsz, s, _ = x.shape
    h = rms_norm(x, ln_g)
    z, xbc, dt_raw, q_a, k_a, v_a, g_a, q_c, g_c = split_projection(jnp.einsum('btd,dn->btn', h, w_in))
    prefix = jnp.zeros((bsz, CONV_W - 1, CONV_DIM), xbc.dtype)
    xbc_c, conv_state = causal_conv(xbc, prefix, conv_w, conv_b)
    xs, bm, cm = ssd_split(xbc_c)
    dt, a = ssd_params(dt_raw, dt_bias, a_log)
    y_ssd, ssm_state = ssd_chunked(xs, dt, a, bm, cm, d_skip.astype(F32))
    pos = jnp.arange(s, dtype=jnp.int32)
    q = rotary(heads(q_a, ATT_HEADS), pos)
    k = rotary(heads(k_a, ATT_HEADS), pos)
    v = heads(v_a, ATT_HEADS)
    o_att = dilated_prompt(q.astype(F32), k.astype(F32), v.astype(F32))
    win = min(MAX_WINDOW, s)
    mk, mv = memory_kv(mem, mem_norm_g, w_mem_kv)
    o_cross = cross_attend(heads(q_c, CROSS_HEADS), mk, mv)
    out = mix_output(y_ssd, z, o_att, g_a, o_cross, g_c, ssd_norm_g, w_out, x.dtype)
    return x + out, (k[:, s - win:], v[:, s - win:], mk, mv, conv_state, ssm_state)


def layer_sample(x, pos, win_k, win_v, mem_k, mem_v, conv_buf, ssm_h,
                 ln_g, w_in, conv_w, conv_b, dt_bias, a_log, d_skip, ssd_norm_g, w_out):
    h = rms_norm(x, ln_g)
    z, xbc, dt_raw, q_a, k_a, v_a, g_a, q_c, g_c = split_projection(jnp.einsum('btd,dn->btn', h, w_in))
    xbc_c, conv_new = causal_conv(xbc, conv_buf, conv_w, conv_b)
    xs, bm, cm = ssd_split(xbc_c)
    dt, a = ssd_params(dt_raw, dt_bias, a_log)
    y_ssd, ssm_new = ssd_recurrent(xs, dt, a, bm, cm, d_skip.astype(F32), ssm_h)
    q = rotary(heads(q_a, ATT_HEADS), pos)
    k = rotary(heads(k_a, ATT_HEADS), pos)
    v = heads(v_a, ATT_HEADS)
    k_all = jnp.concatenate([win_k.astype(F32), k.astype(F32)], axis=1)
    v_all = jnp.concatenate([win_v.astype(F32), v.astype(F32)], axis=1)
    o_att = dilated_sample(q.astype(F32), k_all, v_all, win_k.shape[1])
    o_cross = cross_attend(heads(q_c, CROSS_HEADS), mem_k, mem_v)
    out = mix_output(y_ssd, z, o_att, g_a, o_cross, g_c, ssd_norm_g, w_out, x.dtype)
    return x + out, (k, v, conv_new, ssm_new)


def setup_inputs(seed: int = 0) -> dict:
    key = jax.random.key(seed)
    ks = jax.random.split(key, 24)
    nrm = jax.random.normal
    w_buf = min(MAX_WINDOW, PAST_LEN)
    dt0 = jnp.exp(jax.random.uniform(ks[13], (DEPTH, SSD_HEADS)) * (math.log(0.1) - math.log(0.001)) + math.log(0.001))
    return {
        'x_prompt': nrm(ks[0], (BATCH, SEQ, D_MODEL), F32),
        'x_sample': nrm(ks[1], (DEC_BATCH, DEC_SEQ, D_MODEL), F32),
        'mem_prompt': nrm(ks[2], (BATCH, MEM_LEN, D_MODEL), F32),
        'cache_win_k': nrm(ks[3], (DEPTH, DEC_BATCH, w_buf, ATT_HEADS, ATT_HEAD_DIM), F32),
        'cache_win_v': nrm(ks[4], (DEPTH, DEC_BATCH, w_buf, ATT_HEADS, ATT_HEAD_DIM), F32),
        'cache_mem_k': nrm(ks[5], (DEPTH, DEC_BATCH, MEM_LEN, CROSS_HEADS, CROSS_HEAD_DIM), F32),
        'cache_mem_v': nrm(ks[6], (DEPTH, DEC_BATCH, MEM_LEN, CROSS_HEADS, CROSS_HEAD_DIM), F32),
        'state_conv': nrm(ks[7], (DEPTH, DEC_BATCH, CONV_W - 1, CONV_DIM), F32),
        'state_ssm': 0.5 * nrm(ks[8], (DEPTH, DEC_BATCH, SSD_HEADS, SSD_HEAD_DIM, SSD_STATE), F32),
        'pos_sample': jnp.broadcast_to(PAST_LEN + jnp.arange(DEC_SEQ, dtype=jnp.int32), (DEC_BATCH, DEC_SEQ)).astype(jnp.int32),
        'ln_g': 1.0 + 0.02 * nrm(ks[9], (DEPTH, D_MODEL), F32),
        'w_in': nrm(ks[10], (DEPTH, D_MODEL, N_IN), F32) * D_MODEL ** -0.5,
        'conv_w': nrm(ks[11], (DEPTH, CONV_W, CONV_DIM), F32) * CONV_W ** -0.5,
        'conv_b': 0.02 * nrm(ks[12], (DEPTH, CONV_DIM), F32),
        'dt_bias': dt0 + jnp.log(-jnp.expm1(-dt0)),
        'a_log': jnp.log(jax.random.uniform(ks[14], (DEPTH, SSD_HEADS), F32, 1.0, 16.0)),
        'd_skip': 1.0 + 0.1 * nrm(ks[15], (DEPTH, SSD_HEADS), F32),
        'ssd_norm_g': 1.0 + 0.02 * nrm(ks[16], (DEPTH, SSD_WIDTH), F32),
        'mem_norm_g': 1.0 + 0.02 * nrm(ks[17], (DEPTH, D_MODEL), F32),
        'w_mem_kv': nrm(ks[18], (DEPTH, D_MODEL, 2 * CROSS_WIDTH), F32) * D_MODEL ** -0.5,
        'w_out': nrm(ks[19], (DEPTH, MIX_WIDTH, D_MODEL), F32) * MIX_WIDTH ** -0.5,
        'final_norm_g': 1.0 + 0.02 * nrm(ks[20], (D_MODEL,), F32),
    }


def reference(x_prompt, x_sample, mem_prompt, cache_win_k, cache_win_v, cache_mem_k, cache_mem_v,
              state_conv, state_ssm, pos_sample, ln_g, w_in, conv_w, conv_b, dt_bias, a_log, d_skip,
              ssd_norm_g, mem_norm_g, w_mem_kv, w_out, final_norm_g):
    hp, hs = x_prompt, x_sample
    new_p, new_s = [], []
    for i in range(DEPTH):
        hp, sp = layer_prompt(hp, mem_prompt, ln_g[i], w_in[i], conv_w[i], conv_b[i], dt_bias[i], a_log[i],
                              d_skip[i], ssd_norm_g[i], mem_norm_g[i], w_mem_kv[i], w_out[i])
        hs, ss = layer_sample(hs, pos_sample, cache_win_k[i], cache_win_v[i], cache_mem_k[i], cache_mem_v[i],
                              state_conv[i], state_ssm[i], ln_g[i], w_in[i], conv_w[i], conv_b[i], dt_bias[i],
                              a_log[i], d_skip[i], ssd_norm_g[i], w_out[i])
        new_p.append(sp)
        new_s.append(ss)
    y_prompt = rms_norm(hp, final_norm_g)
    y_sample = rms_norm(hs, final_norm_g)
    win_k_prompt, win_v_prompt, mem_k_prompt, mem_v_prompt, conv_prompt, ssm_prompt = [jnp.stack(a) for a in zip(*new_p)]
    win_k_sample, win_v_sample, conv_sample, ssm_sample = [jnp.stack(a) for a in zip(*new_s)]
    return (y_prompt, y_sample, win_k_prompt, win_v_prompt, mem_k_prompt, mem_v_prompt, conv_prompt, ssm_prompt,
            win_k_sample, win_v_sample, conv_sample, ssm_sample)
```

```cpp
#include <hip/hip_runtime.h>
#include <cstdio>
#include <cstdint>
#include <cmath>
namespace pg8 {
#define PG8_LAS __attribute__((address_space(3)))
typedef unsigned short bf16_t;
typedef short bf16x8 __attribute__((ext_vector_type(8)));
typedef float f32x4 __attribute__((ext_vector_type(4)));
typedef unsigned u32x4 __attribute__((ext_vector_type(4)));
constexpr int BM = 256, BK = 64, HALF = 128, HTB = HALF * BK * 2  , STAGE_BYTES = 8 * HTB, NXCD = 8, WGM = 8;

__host__ __device__ __forceinline__ int lds_byte(int r, int c) { const int st = (r >> 4) * 2 + (c >> 5), rr = r & 15, cc = c & 31, ob = rr * 64 + cc * 2; return st * 1024 + (ob ^ (((ob >> 9) & 1) << 5)); }
__host__ __device__ __forceinline__ void stage_rc(int b, int& R, int& C) { const int st = b / 1024, sb = b % 1024, swz = sb ^ (((sb >> 9) & 1) << 5); R = (st >> 1) * 16 + swz / 64; C = (st & 1) * 32 + (swz % 64) / 2; }
__host__ __device__ __forceinline__ int perm32(int rho) { const int n = rho >> 4, i = rho & 15; return 8 * (i >> 2) + 4 * n + (i & 3); }

struct Unit { int pm, pn; };
struct Gemm { const bf16_t* A; const bf16_t* Bt; int M, N, K; };

struct StaticOrder {
    int nM, nN, nwg, G, c;
    __host__ __device__ void init(int M, int N, int G_, int c_) { nM = M / BM; nN = N / BM; nwg = nM * nN; G = G_; c = c_; }
    __host__ __device__ bool next(int i, Unit& u) const {
        const long L = (long)i * G + c; if (L >= nwg) return false;
        int wgid = (int)L; { const int q = nwg / NXCD, r = nwg % NXCD, xcd = wgid % NXCD, off = wgid / NXCD; wgid = (xcd < r ? xcd * (q + 1) : r * (q + 1) + (xcd - r) * q) + off; }
        const int nig = WGM * nN, gid = wgid / nig, fm = gid * WGM, gsz = (nM - fm) < WGM ? (nM - fm) : WGM;
        u.pm = fm + ((wgid % nig) % gsz); u.pn = (wgid % nig) / gsz; return true;
    }
    __device__ __forceinline__ void a_ready(const Unit&) const {}
    __device__ __forceinline__ void done(const Unit&) const {}
};
__device__ __forceinline__ unsigned cvt_pk_bf16(float lo, float hi) { unsigned r; asm volatile("v_cvt_pk_bf16_f32 %0, %1, %2" : "=v"(r) : "v"(lo), "v"(hi)); return r; }
typedef float f32x2 __attribute__((ext_vector_type(2)));
template <class Epi, class Sched, bool ALIGN_EPI = false, bool SP2 = false>
__device__ __forceinline__ void gemm_phase(PG8_LAS unsigned char* lds, const Gemm g, const Sched& S, const Epi& E) {
    const int tid = threadIdx.x, wid = __builtin_amdgcn_readfirstlane(tid >> 6), lane = tid & 63, wr = wid >> 2, wc = wid & 3, fr = lane & 15, fq = lane >> 4;
    const int K = g.K, nt = K / BK;
    unsigned voffA[2], voffB[2];
#pragma unroll
    for (int i = 0; i < 2; ++i) { int R, C; stage_rc(tid * 16 + i * 8192, R, C); const int Rb = Epi::PERM ? ((R & ~31) + perm32(R & 31)) : R;
        voffA[i] = (unsigned)(R * K + C) * 2u; voffB[i] = (unsigned)(Rb * K + C) * 2u; }
    const size_t kstep = (size_t)(BK * 2);
    const size_t hstep = (size_t)HALF * K * 2;
    const size_t tstep = 2 * hstep;
    const unsigned ldsw = (unsigned)wid * 1024u;
    const int aoff = lds_byte(wr * 64 + fr, fq * 8), boff = lds_byte(wc * 32 + fr, fq * 8);
#define PG8_SA(b, h) (((b) * 2 + (h)) * HTB)
#define PG8_SB(b, h) ((4 + (b) * 2 + (h)) * HTB)
#define PG8_STAGE(bufoff, gbase, voff) do { _Pragma("unroll") for (int _i = 0; _i < 2; ++_i) \
        __builtin_amdgcn_global_load_lds((const unsigned*)((const char*)(gbase) + (voff)[_i]), (PG8_LAS unsigned*)(lds + (bufoff) + ldsw + _i * 8192), 16, 0, 0); } while (0)
#define PG8_LDA(dst, b, h) do { _Pragma("unroll") for (int m = 0; m < 4; ++m) _Pragma("unroll") for (int k = 0; k < 2; ++k) dst[m][k] = *(const PG8_LAS bf16x8*)(lds + PG8_SA(b, h) + aoff + m * 2048 + k * 1024); } while (0)
#define PG8_LDB(dst, b, h) do { _Pragma("unroll") for (int n = 0; n < 2; ++n) _Pragma("unroll") for (int k = 0; k < 2; ++k) dst[n][k] = *(const PG8_LAS bf16x8*)(lds + PG8_SB(b, h) + boff + n * 2048 + k * 1024); } while (0)
#define PG8_MMA(ai, bj, At, Bt) do { __builtin_amdgcn_s_setprio(1); _Pragma("unroll") for (int m = 0; m < 4; ++m) _Pragma("unroll") for (int n = 0; n < 2; ++n) _Pragma("unroll") for (int k = 0; k < 2; ++k) \
        acc[ai][bj][m][n] = __builtin_amdgcn_mfma_f32_16x16x32_bf16(Bt[n][k], At[m][k], acc[ai][bj][m][n], 0, 0, 0); __builtin_amdgcn_s_setprio(0); } while (0)
#define PG8_WAIT_V(n) asm volatile("s_waitcnt vmcnt(" #n ")" ::: "memory")
#define PG8_WAIT_L(n) asm volatile("s_waitcnt lgkmcnt(" #n ")" ::: "memory")
#define PG8_BAR __builtin_amdgcn_s_barrier()
#define PG8_SCHED __builtin_amdgcn_sched_barrier(0)
    Unit cur, nxt; int ui = 0;
    if (!S.next(0, cur)) return;
    f32x4 acc[2][2][4][2];
#pragma unroll
    for (int a = 0; a < 2; ++a)
#pragma unroll
        for (int b = 0; b < 2; ++b)
#pragma unroll
            for (int m = 0; m < 4; ++m)
#pragma unroll
                for (int n = 0; n < 2; ++n) acc[a][b][m][n] = (f32x4){0.f, 0.f, 0.f, 0.f};
    bf16x8 At[4][2], B0[2][2], B1[2][2];
    const char* cA = (const char*)g.A + (size_t)cur.pm * tstep; const char* cB = (const char*)g.Bt + (size_t)cur.pn * tstep;
    S.a_ready(cur);
    if constexpr (SP2) {
        PG8_STAGE(PG8_SB(0, 0), cB, voffB); PG8_STAGE(PG8_SB(0, 1), cB + hstep, voffB); PG8_STAGE(PG8_SA(0, 0), cA, voffA); PG8_STAGE(PG8_SA(0, 1), cA + hstep, voffA);
        if (wr == 1) PG8_BAR;
        PG8_WAIT_V(2); PG8_BAR;
        PG8_STAGE(PG8_SB(1, 0), cB + kstep, voffB); PG8_STAGE(PG8_SA(1, 0), cA + kstep, voffA); PG8_STAGE(PG8_SB(1, 1), cB + hstep + kstep, voffB);
        PG8_WAIT_V(6); PG8_BAR;
    } else {
        PG8_STAGE(PG8_SB(0, 0), cB, voffB); PG8_STAGE(PG8_SA(0, 0), cA, voffA); PG8_STAGE(PG8_SB(0, 1), cB + hstep, voffB); PG8_STAGE(PG8_SA(0, 1), cA + hstep, voffA);
        if (wr == 1) PG8_BAR;
        PG8_WAIT_V(4); PG8_BAR;
        PG8_STAGE(PG8_SB(1, 0), cB + kstep, voffB); PG8_STAGE(PG8_SA(1, 0), cA + kstep, voffA); PG8_STAGE(PG8_SB(1, 1), cB + hstep + kstep, voffB);
        PG8_WAIT_V(6); PG8_BAR;
    }
    for (;;) {
        const bool has_next = S.next(ui + 1, nxt);
        const char* nA = has_next ? (const char*)g.A + (size_t)nxt.pm * tstep : cA; const char* nB = has_next ? (const char*)g.Bt + (size_t)nxt.pn * tstep : cB;
        for (int t = 0; t < nt; t += 2) {
            const bool last = (t == nt - 2);
            const char* a1 = cA + (size_t)(t + 1) * kstep;
            const char* a2 = last ? nA : cA + (size_t)(t + 2) * kstep; const char* b2 = last ? nB : cB + (size_t)(t + 2) * kstep;
            const char* a3 = a2 + kstep; const char* b3 = b2 + kstep;
            if (last && has_next) S.a_ready(nxt);
            if constexpr (SP2) {
            PG8_LDB(B0, 0, 0); PG8_LDB(B1, 0, 1); PG8_SCHED; PG8_LDA(At, 0, 0); PG8_STAGE(PG8_SA(1, 1), a1 + hstep, voffA);
            PG8_WAIT_V(8); PG8_WAIT_L(0); PG8_BAR; PG8_MMA(0, 0, At, B0); PG8_MMA(0, 1, At, B1); PG8_BAR; PG8_SCHED;
            PG8_LDA(At, 0, 1); PG8_STAGE(PG8_SB(0, 0), b2, voffB); PG8_STAGE(PG8_SB(0, 1), b2 + hstep, voffB); PG8_STAGE(PG8_SA(0, 0), a2, voffA);
            PG8_WAIT_V(8); PG8_WAIT_L(0); PG8_BAR; PG8_MMA(1, 0, At, B0); PG8_MMA(1, 1, At, B1); PG8_BAR; PG8_SCHED;
            PG8_LDB(B0, 1, 0); PG8_LDB(B1, 1, 1); PG8_SCHED; PG8_LDA(At, 1, 0); PG8_STAGE(PG8_SA(0, 1), a2 + hstep, voffA);
            PG8_WAIT_V(8); PG8_WAIT_L(0); PG8_BAR; PG8_MMA(0, 0, At, B0); PG8_MMA(0, 1, At, B1); PG8_BAR; PG8_SCHED;
            PG8_LDA(At, 1, 1); PG8_STAGE(PG8_SB(1, 0), b3, voffB); PG8_STAGE(PG8_SB(1, 1), b3 + hstep, voffB); PG8_STAGE(PG8_SA(1, 0), a3, voffA);
            PG8_WAIT_V(8); PG8_WAIT_L(0); PG8_BAR; PG8_MMA(1, 0, At, B0); PG8_MMA(1, 1, At, B1); PG8_BAR; PG8_SCHED;
            } else {
            PG8_LDB(B0, 0, 0); PG8_SCHED; PG8_LDA(At, 0, 0); PG8_STAGE(PG8_SA(1, 1), a1 + hstep, voffA);
            PG8_WAIT_L(8); PG8_BAR; PG8_WAIT_L(0); PG8_MMA(0, 0, At, B0); PG8_BAR; PG8_SCHED;
            PG8_LDB(B1, 0, 1); PG8_STAGE(PG8_SB(0, 0), b2, voffB);
            PG8_BAR; PG8_WAIT_L(0); PG8_MMA(0, 1, At, B1); PG8_BAR;
            PG8_LDA(At, 0, 1); PG8_STAGE(PG8_SA(0, 0), a2, voffA);
            PG8_BAR; PG8_WAIT_L(0); PG8_MMA(1, 0, At, B0); PG8_BAR; PG8_SCHED;
            PG8_STAGE(PG8_SB(0, 1), b2 + hstep, voffB);
            PG8_WAIT_V(6); PG8_BAR; PG8_MMA(1, 1, At, B1); PG8_BAR;
            PG8_LDB(B0, 1, 0); PG8_SCHED; PG8_LDA(At, 1, 0); PG8_STAGE(PG8_SA(0, 1), a2 + hstep, voffA);
            PG8_WAIT_L(8); PG8_BAR; PG8_WAIT_L(0); PG8_MMA(0, 0, At, B0); PG8_BAR; PG8_SCHED;
            PG8_LDB(B1, 1, 1); PG8_STAGE(PG8_SB(1, 0), b3, voffB);
            PG8_BAR; PG8_WAIT_L(0); PG8_MMA(0, 1, At, B1); PG8_BAR;
            PG8_LDA(At, 1, 1); PG8_STAGE(PG8_SA(1, 0), a3, voffA);
            PG8_BAR; PG8_WAIT_L(0); PG8_MMA(1, 0, At, B0); PG8_BAR; PG8_SCHED;
            PG8_STAGE(PG8_SB(1, 1), b3 + hstep, voffB);
            PG8_WAIT_V(6); PG8_BAR; PG8_MMA(1, 1, At, B1); PG8_BAR;
            }
        }
        if constexpr (ALIGN_EPI) { if (wr == 0) PG8_BAR; }
        if constexpr (!Epi::AFTER_DRAIN) { E(acc, cur, wr, wc, fr, fq); S.done(cur); }
        if (!has_next) break;
#pragma unroll
        for (int a = 0; a < 2; ++a)
#pragma unroll
            for (int b = 0; b < 2; ++b)
#pragma unroll
                for (int m = 0; m < 4; ++m)
#pragma unroll
                    for (int n = 0; n < 2; ++n) acc[a][b][m][n] = (f32x4){0.f, 0.f, 0.f, 0.f};
        cur = nxt; cA = nA; cB = nB; ++ui;
        if constexpr (ALIGN_EPI) { if (wr == 1) PG8_BAR; }
    }
    PG8_WAIT_V(0);
    if constexpr (!ALIGN_EPI) { if (wr == 0) PG8_BAR; }
    PG8_BAR;
    if constexpr (Epi::AFTER_DRAIN) { E.fused(acc, cur, wr, wc, fr, fq, lds, wid, lane); S.done(cur); }
#undef PG8_SA
#undef PG8_SB
#undef PG8_STAGE
#undef PG8_LDA
#undef PG8_LDB
#undef PG8_MMA
#undef PG8_WAIT_V
#undef PG8_WAIT_L
#undef PG8_BAR
#undef PG8_SCHED
}
}
#define GAS __attribute__((address_space(1)))
#define LAS __attribute__((address_space(3)))
typedef unsigned short bf16;
typedef unsigned v4u __attribute__((ext_vector_type(4)));
using pg8::f32x4;
using pg8::bf16x8;
typedef GAS unsigned gu32;
typedef GAS unsigned long long gu64;
#define RLX_AGENT __ATOMIC_RELAXED, __HIP_MEMORY_SCOPE_AGENT
#define LDS_WAIT() asm volatile("s_waitcnt lgkmcnt(0)" ::: "memory")
#define VM_WAIT() asm volatile("s_waitcnt vmcnt(0)" ::: "memory")
__device__ __forceinline__ unsigned long long rt() { return __builtin_amdgcn_s_memrealtime(); }
__device__ __forceinline__ unsigned f2bf(float f) { unsigned u = __builtin_bit_cast(unsigned, f); return (u + 0x7fffu + ((u >> 16) & 1u)) >> 16; }
__device__ __forceinline__ unsigned pk2(float lo, float hi) { return f2bf(lo) | (f2bf(hi) << 16); }

#define XB_TMO      128
#define XB_XCNT(j)  (256  + 64 * (j))
#define XB_XSUB(j)  (1280 + 64 * (j))
#define XB_XGEN(j)  (2304 + 64 * (j))
#define XB_TOP      3328
#define XB_TOPGEN   3392
#define XCD_BAR_WORDS 3456
#define XB_SPIN_CAP (1u << 18)

__device__ __forceinline__ unsigned xb_ld(unsigned* p)              { return __hip_atomic_load(p, __ATOMIC_RELAXED, __HIP_MEMORY_SCOPE_AGENT); }
__device__ __forceinline__ unsigned xb_add(unsigned* p, unsigned v) { return __hip_atomic_fetch_add(p, v, __ATOMIC_RELAXED, __HIP_MEMORY_SCOPE_AGENT); }
__device__ __forceinline__ unsigned xb_xcc_id() { return (unsigned)__builtin_amdgcn_s_getreg((3 << 11) | 20) & 0xFu; }
#define XB_SPIN(cond, bar) do { unsigned _sp = 0; while (cond) { __builtin_amdgcn_s_sleep(1); \
    if ((++_sp & 255u) == 0u) { if (xb_ld(&(bar)[XB_TMO])) break; if (_sp > XB_SPIN_CAP) { atomicAdd(&(bar)[XB_TMO], 1u); break; } } } } while (0)

struct XcdBarrier {
    unsigned* bar; unsigned x;
    volatile LAS unsigned* st;
};

__device__ __forceinline__ XcdBarrier xcd_barrier_post(unsigned* bar, volatile LAS unsigned* st) {
    XcdBarrier b; b.bar = bar; b.x = xb_xcc_id(); b.st = st;
    if (threadIdx.x == 0) (void)xb_add(&bar[XB_XCNT(b.x)], 1u);
    return b;
}
__device__ __forceinline__ void xcd_barrier_complete(unsigned* bar, unsigned x, unsigned& nloc, unsigned& nx) {
    const unsigned G = gridDim.x * gridDim.y * gridDim.z;
    unsigned sum, cnt, mine, sp = 0u;
    for (;;) {
        sum = 0u; cnt = 0u; mine = 0u;
#pragma unroll
        for (unsigned j = 0; j < 16; ++j) { const unsigned c = xb_ld(&bar[XB_XCNT(j)]); sum += c; cnt += (c > 0u) ? 1u : 0u; mine = (j == x) ? c : mine; }
        if (sum == G) break;
        __builtin_amdgcn_s_sleep(1);
        if ((++sp & 255u) == 0u) { if (xb_ld(&bar[XB_TMO])) break; if (sp > XB_SPIN_CAP) { atomicAdd(&bar[XB_TMO], 1u); break; } }
    }
    nloc = mine > 0u ? mine : 1u; nx = cnt > 0u ? cnt : 1u;
}

__device__ __forceinline__ void xcd_barrier(const XcdBarrier& b) {
    asm volatile("s_waitcnt vmcnt(0)" ::: "memory");
    __syncthreads();
    if (threadIdx.x == 0) {
        unsigned* bar = b.bar;
        __builtin_amdgcn_s_waitcnt(0);
        unsigned nloc = b.st[0], nx = b.st[1];
        if (nloc == 0u) { xcd_barrier_complete(bar, b.x, nloc, nx); b.st[0] = nloc; b.st[1] = nx; }
        const unsigned old = xb_add(&bar[XB_XSUB(b.x)], 1u);
        const unsigned gen = old / nloc;
        if (old + 1u == (gen + 1u) * nloc) {
            __builtin_amdgcn_fence(__ATOMIC_RELEASE, "agent");
            asm volatile("s_waitcnt vmcnt(0)" ::: "memory");
            const unsigned og = xb_add(&bar[XB_TOP], 1u);
            const unsigned tg = og / nx;
            if (og + 1u == (tg + 1u) * nx) xb_add(&bar[XB_TOPGEN], 1u);
            else XB_SPIN(xb_ld(&bar[XB_TOPGEN]) == tg, bar);
            __builtin_amdgcn_fence(__ATOMIC_ACQUIRE, "agent");
            xb_add(&bar[XB_XGEN(b.x)], 1u);
            asm volatile("s_waitcnt vmcnt(0)" ::: "memory");
        } else {
            XB_SPIN(xb_ld(&bar[XB_XGEN(b.x)]) == gen, bar);
            __builtin_amdgcn_fence(__ATOMIC_ACQUIRE, "agent");
            asm volatile("s_waitcnt vmcnt(0)" ::: "memory");
        }
    }
    __syncthreads();
}

constexpr int DM = 1024, NB = 8, SEQ = 4096, MP = NB * SEQ, NS = 128;
constexpr int RTOT = 33024;
constexpr int MEMR = 2048;
constexpr int XNR = RTOT + MEMR;
constexpr int NIN = 6160, NMAIN = 6144, NMEMC = 1024, NTOT = NMAIN + NMEMC;
constexpr int TM_MAIN = RTOT / 256, TN_MAIN = NMAIN / 256, TM_MEM = MEMR / 256, TN_MEM = NMEMC / 256;
constexpr int NU_MAIN = TM_MAIN * TN_MAIN, NU_MEM = TM_MEM * TN_MEM;
constexpr int CONVD = 2048, NHS = 16, NGRP = 4, PH = 64, NST = 128, LCH = 128, NCH = SEQ / LCH;
constexpr int AH = 8, AD = 64, AW = 512, CH_ = 4, CD = 128, MEML = 256, WBUF = 2048;
constexpr float EPS = 1e-6f;
constexpr float C2A = 0.125f * 1.4426950408889634f;
constexpr float C2C = 0.08838834764831845f * 1.4426950408889634f;
constexpr int ROPE_ROWS = 4096 + 256;
enum { I_XP = 0, I_XS, I_MEM, I_CWK, I_CWV, I_CMK, I_CMV, I_SCONV, I_SSSM, I_POS, I_LNG, I_WIN, I_CONVW, I_CONVB, I_DTB, I_ALOG, I_DSKIP, I_SSDG, I_MEMG, I_WMEM, I_WOUT, I_FNG, N_INPUTS };
constexpr size_t O_YP = 0, O_YS = O_YP + (size_t)MP * DM, O_WKP = O_YS + (size_t)NS * DM, O_WVP = O_WKP + (size_t)NB * WBUF * AW, O_MKP = O_WVP + (size_t)NB * WBUF * AW,
                 O_MVP = O_MKP + (size_t)MEMR * 512, O_CVP = O_MVP + (size_t)MEMR * 512, O_SSP = O_CVP + (size_t)NB * 3 * CONVD, O_WKS = O_SSP + (size_t)NB * NHS * PH * NST,
                 O_WVS = O_WKS + (size_t)NS * AW, O_CVS = O_WVS + (size_t)NS * AW, O_SSS = O_CVS + (size_t)NS * 3 * CONVD, O_END = O_SSS + (size_t)NS * NHS * PH * NST;
static_assert(O_END == 71352320, "output size");

constexpr size_t MiB = 1u << 20;
constexpr size_t WS_CTL = 0, CTL_ZERO_BYTES = 1 * MiB;
constexpr size_t WS_WT = 2 * MiB;
constexpr size_t WS_WOT = 16 * MiB;
constexpr size_t WS_ROPE = 21 * MiB;
constexpr size_t WS_RSTD = 22 * MiB;
constexpr size_t WS_DT = 23 * MiB;
constexpr size_t WS_CSUM = 26 * MiB;
constexpr size_t WS_CDEC = 28 * MiB;
constexpr size_t WS_XN = 32 * MiB;
constexpr size_t WS_SZ = 104 * MiB;
constexpr size_t WS_XBC = 172 * MiB;
constexpr size_t WS_Q = 304 * MiB, WS_K = 338 * MiB, WS_V = 372 * MiB, WS_GA = 406 * MiB, WS_QC = 440 * MiB, WS_GC = 474 * MiB;
constexpr size_t WS_MK = 508 * MiB, WS_MV = 510 * MiB;
constexpr size_t WS_OPART = 512 * MiB;
constexpr size_t WS_ML = 608 * MiB;
constexpr size_t WS_STL = 616 * MiB;
constexpr size_t WS_SPREV = 744 * MiB;
constexpr size_t WS_CAT = 808 * MiB;
constexpr size_t WS_SMP = 940 * MiB;
constexpr size_t WS_END = 944 * MiB;
static_assert(WS_XN + (size_t)XNR * DM * 2 <= WS_SZ && WS_SZ + (size_t)RTOT * DM * 2 <= WS_XBC && WS_XBC + (size_t)RTOT * CONVD * 2 <= WS_Q && WS_GC + (size_t)RTOT * 512 * 2 <= WS_MK, "ws map");
static_assert(WS_CAT + (size_t)RTOT * 2048 * 2 <= WS_SMP && WS_WT + (size_t)NTOT * DM * 2 <= WS_WOT, "ws map 2");
constexpr int CW_TMO = 0, CW_CODE = 1, CW_BAR = 4096;

constexpr int LDS_BYTES = 147456;
constexpr int MISC_OFF = LDS_BYTES - 128;
constexpr int SCR_BYTES = MISC_OFF;
constexpr int NWAVES = 8;

struct Frame {
    LAS unsigned char* lds;
    volatile LAS unsigned* MISC;
    gu32* ctl;
    int tid, lane, wave, vcu, G;
    const float *xp, *xs, *mem, *cwk, *cwv, *cmk, *cmv, *sconv, *sssm, *pos, *lng, *win, *convw, *convb, *dtb, *alog, *dskip, *ssdg, *memg, *wmem, *wout, *fng;
    float* out; unsigned char* ws;
};
__device__ __forceinline__ float wave_sum(float v) {
#pragma unroll
    for (int o = 1; o < 64; o <<= 1) v += __shfl_xor(v, o);
    return v;
}
__device__ __forceinline__ float fast_exp2(float x) { return __builtin_amdgcn_exp2f(x); }
__device__ __forceinline__ float fast_rcp(float x) { return __builtin_amdgcn_rcpf(x); }
__device__ __forceinline__ float silu_f(float x) { return x * fast_rcp(1.0f + fast_exp2(-1.4426950408889634f * x)); }

__device__ __forceinline__ void p0_transpose_item(const float* W, int ldw, int col0, const float* gain, bf16* WT, int K, int nrow0, int k0, LAS float* scr, int lane) {
#pragma unroll 8
    for (int i = 0; i < 32; ++i) { const int kk = 2 * i + (lane >> 5); float v = W[(size_t)(k0 + kk) * ldw + col0 + (lane & 31)]; if (gain) v *= gain[k0 + kk]; scr[kk * 33 + (lane & 31)] = v; }
    LDS_WAIT(); asm volatile("" ::: "memory");
    const int c = lane & 7;
#pragma unroll
    for (int j = 0; j < 4; ++j) { const int n = (lane >> 3) + 8 * j; const LAS float* s = scr + (8 * c) * 33 + n;
        v4u o; o.x = pk2(s[0 * 33], s[1 * 33]); o.y = pk2(s[2 * 33], s[3 * 33]); o.z = pk2(s[4 * 33], s[5 * 33]); o.w = pk2(s[6 * 33], s[7 * 33]);
        *(GAS v4u*)(WT + (size_t)(nrow0 + n) * K + k0 + 8 * c) = o; }
    LDS_WAIT(); asm volatile("" ::: "memory");
}
template <int KIND> __device__ __forceinline__ void p0_row_item(Frame& F, int row0, const float* src0, const LAS float* gw4) {
    const int lane = F.lane, r = lane & 15, q = lane >> 4, row = row0 + r;
    constexpr bool with_dt = KIND == 0, zero = KIND == 1;
    const float* src = src0 + (size_t)r * DM;
    bf16* dst = (bf16*)(F.ws + WS_XN) + (size_t)row * DM;
    f32x4 acc = {0.f, 0.f, 0.f, 0.f}; float ss = 0.f;
    if (zero) {
#pragma unroll 4
        for (int kb = 0; kb < 16; ++kb) { v4u z = {0u, 0u, 0u, 0u}; *(GAS v4u*)(dst + 64 * kb + 16 * q) = z; *(GAS v4u*)(dst + 64 * kb + 16 * q + 8) = z; }
        if (q == 0) ((float*)(F.ws + WS_RSTD))[row] = 0.f;
        return;
    }
#pragma unroll 2
    for (int kb = 0; kb < 16; ++kb) {
        f32x4 v[4];
#pragma unroll
        for (int e = 0; e < 4; ++e) v[e] = *(const GAS f32x4*)(src + 64 * kb + 16 * q + 4 * e);
#pragma unroll
        for (int e = 0; e < 4; ++e) ss += (v[e].x * v[e].x + v[e].y * v[e].y) + (v[e].z * v[e].z + v[e].w * v[e].w);
        v4u o0, o1;
        o0.x = pk2(v[0].x, v[0].y); o0.y = pk2(v[0].z, v[0].w); o0.z = pk2(v[1].x, v[1].y); o0.w = pk2(v[1].z, v[1].w);
        o1.x = pk2(v[2].x, v[2].y); o1.y = pk2(v[2].z, v[2].w); o1.z = pk2(v[3].x, v[3].y); o1.w = pk2(v[3].z, v[3].w);
        *(GAS v4u*)(dst + 64 * kb + 16 * q) = o0; *(GAS v4u*)(dst + 64 * kb + 16 * q + 8) = o1;
        if (with_dt) {
#pragma unroll
            for (int e4 = 0; e4 < 4; ++e4) { const f32x4 w = *(const LAS f32x4*)(gw4 + ((16 * kb + 4 * q + e4) * 16 + r) * 4);
                acc = __builtin_amdgcn_mfma_f32_16x16x4f32(v[e4].x, w.x, acc, 0, 0, 0); acc = __builtin_amdgcn_mfma_f32_16x16x4f32(v[e4].y, w.y, acc, 0, 0, 0);
                acc = __builtin_amdgcn_mfma_f32_16x16x4f32(v[e4].z, w.z, acc, 0, 0, 0); acc = __builtin_amdgcn_mfma_f32_16x16x4f32(v[e4].w, w.w, acc, 0, 0, 0); }
        }
    }
    ss += __shfl_xor(ss, 16); ss += __shfl_xor(ss, 32);
    const float rstd = 1.0f / sqrtf(ss * (1.0f / DM) + EPS);
    if (q == 0) ((float*)(F.ws + WS_RSTD))[row] = rstd;
    if (with_dt) {
        const float bias = F.dtb[r]; float* DT = (float*)(F.ws + WS_DT);
#pragma unroll
        for (int g = 0; g < 4; ++g) { const float rs = __shfl(rstd, 4 * q + g); const float v = acc[g] * rs + bias;
            const float sp = fmaxf(v, 0.f) + log1pf(expf(-fabsf(v))); DT[(size_t)(row0 + 4 * q + g) * 16 + r] = sp; }
    }
}
__device__ __forceinline__ void p0_prologue(Frame& F) {
    LAS float* gw4 = (LAS float*)F.lds;
    LAS float* scr = (LAS float*)(F.lds + 65536 + F.wave * 8448);
    { const float* W = F.win; const float* g = F.lng;
      for (int idx = F.tid; idx < 1024 * 16; idx += NWAVES * 64) { const int k = idx >> 4, j = idx & 15; gw4[((k >> 2) * 16 + j) * 4 + (k & 3)] = W[(size_t)k * NIN + 3072 + j] * g[k]; } }
    __syncthreads();
    const int gw = F.vcu * NWAVES + F.wave, NGW = F.G * NWAVES;
    for (int it = gw; it < MP / 16; it += NGW) p0_row_item<0>(F, it * 16, F.xp + (size_t)it * 16 * DM, gw4);
    for (int it = gw; it < NS / 16; it += NGW) p0_row_item<0>(F, MP + it * 16, F.xs + (size_t)it * 16 * DM, gw4);
    for (int it = gw; it < (RTOT - MP - NS) / 16; it += NGW) p0_row_item<1>(F, MP + NS + it * 16, nullptr, gw4);
    for (int it = gw; it < MEMR / 16; it += NGW) p0_row_item<2>(F, RTOT + it * 16, F.mem + (size_t)it * 16 * DM, gw4);
    constexpr int I_A = 16 * 192, I_B = 16 * 32, I_C = 32 * 32;
    bf16* WT = (bf16*)(F.ws + WS_WT); bf16* WOT = (bf16*)(F.ws + WS_WOT);
    for (int it = gw; it < I_A + I_B + I_C; it += NGW) {
        int r = it;
        if (r < I_A) { const int kb = r / 192, nb = r % 192, n0 = nb * 32; p0_transpose_item(F.win, NIN, n0 < 3072 ? n0 : n0 + 16, F.lng, WT, DM, n0, kb * 64, scr, F.lane); continue; } r -= I_A;
        if (r < I_B) { const int kb = r / 32, nb = r % 32; p0_transpose_item(F.wmem, 1024, nb * 32, F.memg, WT, DM, NMAIN + nb * 32, kb * 64, scr, F.lane); continue; } r -= I_B;
        { const int kb = r / 32, nb = r % 32; p0_transpose_item(F.wout, 1024, nb * 32, nullptr, WOT, 2048, nb * 32, kb * 64, scr, F.lane); }
    }
    { float* rope = (float*)(F.ws + WS_ROPE); const int* pos = (const int*)F.pos;
      const int gt = F.vcu * (NWAVES * 64) + F.tid, NGT = F.G * NWAVES * 64;
      for (int idx = gt; idx < ROPE_ROWS * 8; idx += NGT) { const int pi = idx >> 3, i = idx & 7; const int p = pi < 4096 ? pi : (pi < 4096 + NS ? pos[pi - 4096] : 0);
          const float inv = (float)exp2(-(double)i * 2.3664460711655217); const float ang = (float)p * inv; rope[pi * 16 + i] = cosf(ang); rope[pi * 16 + 8 + i] = sinf(ang); } }
}

__device__ __forceinline__ void st8_bf16(bf16* p, const f32x4 a, const f32x4 b) { v4u w; w.x = pg8::cvt_pk_bf16(a.x, a.y); w.y = pg8::cvt_pk_bf16(a.z, a.w); w.z = pg8::cvt_pk_bf16(b.x, b.y); w.w = pg8::cvt_pk_bf16(b.z, b.w); *(GAS v4u*)p = w; }
__device__ __forceinline__ void st8_f32(float* p, const f32x4 a, const f32x4 b) { *(GAS f32x4*)p = a; *(GAS f32x4*)(p + 4) = b; }
__device__ __forceinline__ f32x4 silu4(const f32x4 v) { f32x4 o; o.x = silu_f(v.x); o.y = silu_f(v.y); o.z = silu_f(v.z); o.w = silu_f(v.w); return o; }
__device__ __forceinline__ f32x4 shx16(const f32x4 v) { f32x4 o; o.x = __shfl_xor(v.x, 16); o.y = __shfl_xor(v.y, 16); o.z = __shfl_xor(v.z, 16); o.w = __shfl_xor(v.w, 16); return o; }
enum { TK_Z = 0, TK_XBC, TK_Q, TK_K, TK_V, TK_GA, TK_QC, TK_GC, TK_MEM };
struct Epi1 {
    static constexpr bool PERM = true, AFTER_DRAIN = false;
    const float* rstd; const float* rope; float* out; unsigned char* ws;
    template <int T> __device__ __forceinline__ void tile(const pg8::f32x4 (&acc)[2][2][4][2], const pg8::Unit& u, int wr, int wc, int fr, int fq) const {
        const int pm = u.pm, pn = u.pn, lc = wc * 32 + 8 * fq, rbase = pm * 256 + wr * 64 + fr;
        bf16* O; int ld, col0;
        if (T == TK_Z) { O = (bf16*)(ws + WS_SZ); ld = 1024; col0 = pn * 256; }
        else if (T == TK_XBC) { O = (bf16*)(ws + WS_XBC); ld = 2048; col0 = (pn - 4) * 256; }
        else if (T == TK_MEM) { O = (bf16*)(ws + (pn < 26 ? WS_MK : WS_MV)); ld = 512; col0 = (pn & 1) * 256; }
        else { O = (bf16*)(ws + WS_Q + (size_t)((pn - 12) >> 1) * (34 * MiB)); ld = 512; col0 = (pn & 1) * 256; }
        const bool rotw = (T == TK_Q || T == TK_K) && ((wc & 1) == 0);
        const float sgn = fq == 0 ? -1.f : 1.f;
        float rsv[2][4];
#pragma unroll
        for (int ai = 0; ai < 2; ++ai)
#pragma unroll
            for (int m = 0; m < 4; ++m) rsv[ai][m] = rstd[rbase + ai * 128 + m * 16];
#pragma unroll
        for (int ai = 0; ai < 2; ++ai)
#pragma unroll
            for (int m = 0; m < 4; ++m) {
                const int row = rbase + ai * 128 + m * 16; const float rs = rsv[ai][m];
                f32x4 c0, c1, s0, s1;
                if (T == TK_Q || T == TK_K) { if (rotw && fq < 2) { const int prow = row < MP ? (row & 4095) : 4096 + (row - MP); const float* rp = rope + (size_t)prow * 16;
                    c0 = *(const GAS f32x4*)rp; c1 = *(const GAS f32x4*)(rp + 4); s0 = *(const GAS f32x4*)(rp + 8) * sgn; s1 = *(const GAS f32x4*)(rp + 12) * sgn; } }
#pragma unroll
                for (int bj = 0; bj < 2; ++bj) {
                    f32x4 a = acc[ai][bj][m][0] * rs, b = acc[ai][bj][m][1] * rs; const int col = col0 + bj * 128 + lc;
                    if (T == TK_Q || T == TK_K) { if (rotw) { const f32x4 pa = shx16(a), pb = shx16(b); if (fq < 2) { a = a * c0 + pa * s0; b = b * c1 + pb * s1; } } }
                    if (T == TK_Z || T == TK_GA || T == TK_GC) { a = silu4(a); b = silu4(b); }
                    if (T == TK_Q) { a = a * C2A; b = b * C2A; }
                    if (T == TK_QC) { a = a * C2C; b = b * C2C; }
                    if (T == TK_MEM) { const int mrow = row - RTOT; st8_bf16(O + (size_t)mrow * ld + col, a, b); st8_f32(out + (pn < 26 ? O_MKP : O_MVP) + (size_t)mrow * 512 + col, a, b); }
                    else {
                        st8_bf16(O + (size_t)row * ld + col, a, b);
                        if (T == TK_K || T == TK_V) {
                            if (pm < 128) { if ((pm & 15) >= 8) { const int bb = row >> 12, s = row & 4095; st8_f32(out + (T == TK_K ? O_WKP : O_WVP) + ((size_t)bb * WBUF + (s - 2048)) * AW + col, a, b); } }
                            else if (row < MP + NS) st8_f32(out + (T == TK_K ? O_WKS : O_WVS) + (size_t)(row - MP) * AW + col, a, b);
                        }
                        if (T == TK_XBC) {
                            if (pm < 128) { if ((pm & 15) == 15) { const int bb = row >> 12, s = row & 4095; if (s >= 4093) st8_f32(out + O_CVP + ((size_t)bb * 3 + (s - 4093)) * CONVD + col, a, b); } }
                            else if (row < MP + NS) st8_f32(out + O_CVS + ((size_t)(row - MP) * 3 + 2) * CONVD + col, a, b);
                        }
                    }
                }
            }
    }
    __device__ __forceinline__ void operator()(const pg8::f32x4 (&acc)[2][2][4][2], const pg8::Unit& u, int wr, int wc, int fr, int fq) const {
        const int pn = u.pn;
        if (pn < 4) tile<TK_Z>(acc, u, wr, wc, fr, fq);
        else if (pn < 12) tile<TK_XBC>(acc, u, wr, wc, fr, fq);
        else if (pn < 14) tile<TK_Q>(acc, u, wr, wc, fr, fq);
        else if (pn < 16) tile<TK_K>(acc, u, wr, wc, fr, fq);
        else if (pn < 18) tile<TK_V>(acc, u, wr, wc, fr, fq);
        else if (pn < 20) tile<TK_GA>(acc, u, wr, wc, fr, fq);
        else if (pn < 22) tile<TK_QC>(acc, u, wr, wc, fr, fq);
        else if (pn < 24) tile<TK_GC>(acc, u, wr, wc, fr, fq);
        else tile<TK_MEM>(acc, u, wr, wc, fr, fq);
    }
};
struct Sched1 {
    int G, c;
    __device__ __forceinline__ bool next(int i, pg8::Unit& u) const {
        const int L = i * G + c; if (L >= NU_MAIN + NU_MEM) return false;
        if (L < NU_MAIN) {
            constexpr int nM = TM_MAIN, nN = TN_MAIN, nwg = NU_MAIN, q = nwg / 8, r = nwg % 8;
            const int xcd = L % 8, off = L / 8; const int wgid = (xcd < r ? xcd * (q + 1) : r * (q + 1) + (xcd - r) * q) + off;
            constexpr int nig = pg8::WGM * nN; const int gid = wgid / nig, fm = gid * pg8::WGM, gsz = (nM - fm) < pg8::WGM ? (nM - fm) : pg8::WGM;
            u.pm = fm + ((wgid % nig) % gsz); u.pn = (wgid % nig) / gsz;
        } else { const int t = L - NU_MAIN; u.pm = TM_MAIN + (t >> 2); u.pn = TN_MAIN + (t & 3); }
        return true;
    }
    __device__ __forceinline__ void a_ready(const pg8::Unit&) const {}
    __device__ __forceinline__ void done(const pg8::Unit&) const {}
};

typedef short s16x4 __attribute__((ext_vector_type(4)));
typedef short v4i16_t __attribute__((ext_vector_type(4)));
typedef const LAS unsigned char* lcp;
#define MFMA16(a, b, c) __builtin_amdgcn_mfma_f32_16x16x32_bf16((a), (b), (c), 0, 0, 0)
__device__ __forceinline__ s16x4 tr64(lcp p) { return __builtin_bit_cast(s16x4, __builtin_amdgcn_ds_read_tr16_b64_v4i16((LAS v4i16_t*)p)); }
__device__ __forceinline__ bf16x8 frag_row(lcp base, int ldb, int r0, int k0, int lane) { return *(const LAS bf16x8*)(base + (r0 + (lane & 15)) * ldb + (k0 + 8 * (lane >> 4)) * 2); }
__device__ __forceinline__ bf16x8 frag_tr2(lcp base, int ldb, int kA, int kB, int c0, int lane) {
    const int g = lane >> 4, i = lane & 15, q = i >> 2, p = i & 3;
    const s16x4 lo = tr64(base + (kA + 4 * g + q) * ldb + (c0 + 4 * p) * 2), hi = tr64(base + (kB + 4 * g + q) * ldb + (c0 + 4 * p) * 2);
    bf16x8 r; r[0] = lo[0]; r[1] = lo[1]; r[2] = lo[2]; r[3] = lo[3]; r[4] = hi[0]; r[5] = hi[1]; r[6] = hi[2]; r[7] = hi[3]; return r;
}
__device__ __forceinline__ bf16x8 frag_tr(lcp base, int ldb, int k0, int c0, int lane) { const int g = lane >> 4; return frag_tr2(base, ldb, k0 + 4 * g, k0 + 4 * g + 4, c0, lane); }
__device__ __forceinline__ bf16x8 pack8(const f32x4 a, const f32x4 b) {
    v4u w; w.x = pg8::cvt_pk_bf16(a.x, a.y); w.y = pg8::cvt_pk_bf16(a.z, a.w); w.z = pg8::cvt_pk_bf16(b.x, b.y); w.w = pg8::cvt_pk_bf16(b.z, b.w); return __builtin_bit_cast(bf16x8, w); }
__device__ __forceinline__ float bf2f(unsigned short h) { return __uint_as_float((unsigned)h << 16); }
typedef unsigned v2u __attribute__((ext_vector_type(2)));
typedef float f32x2 __attribute__((ext_vector_type(2)));

constexpr int AT_LD = 144, AT_ROWS = 400, AT_VOFF = AT_ROWS * AT_LD;
__device__ __forceinline__ void attn_unit(Frame& F, int u) {
    const int bh = u / 48, v = u % 48, di = v >> 4, w16 = v & 15;
    const int b = bh >> 3, h = bh & 7;
    const int dil = di == 0 ? 1 : (di == 1 ? 4 : 16);
    const int r = di == 0 ? 0 : (di == 1 ? (w16 >> 2) : w16), qblk = di == 0 ? w16 : (di == 1 ? (w16 & 3) : 0);
    const bf16* Qg = (const bf16*)(F.ws + WS_Q); const bf16* Kg = (const bf16*)(F.ws + WS_K); const bf16* Vg = (const bf16*)(F.ws + WS_V);
    LAS unsigned char* lds = F.lds;
    __syncthreads();
    for (int idx = F.tid; idx < AT_ROWS * 8; idx += NWAVES * 64) {
        const int row = idx >> 3, ch = idx & 7; const int sidx = 256 * qblk - 128 + row;
        v4u kv = {0u, 0u, 0u, 0u}, vv = {0u, 0u, 0u, 0u};
        if (row < 384 && sidx >= 0) { const size_t g = ((size_t)b * SEQ + r + (size_t)dil * sidx) * AW + h * AD + ch * 8; kv = *(const GAS v4u*)(Kg + g); vv = *(const GAS v4u*)(Vg + g); }
        *(LAS v4u*)(lds + row * AT_LD + ch * 16) = kv; *(LAS v4u*)(lds + AT_VOFF + row * AT_LD + ch * 16) = vv;
    }
    __syncthreads();
    const int lane = F.lane, g4 = lane >> 4, ql = lane & 15;
#pragma unroll 1
    for (int it = 0; it < 2; ++it) {
        const int qi0 = 32 * F.wave + 16 * it;
        const size_t qrow = (size_t)b * SEQ + r + (size_t)dil * (256 * qblk + qi0 + ql);
        bf16x8 qf[2];
#pragma unroll
        for (int ks = 0; ks < 2; ++ks) qf[ks] = *(const GAS bf16x8*)(Qg + qrow * AW + h * AD + 32 * ks + 8 * g4);
        f32x4 sc[9];
#pragma unroll
        for (int t = 0; t < 9; ++t) { sc[t] = (f32x4){0.f, 0.f, 0.f, 0.f};
#pragma unroll
            for (int ks = 0; ks < 2; ++ks) sc[t] = MFMA16(frag_row(lds, AT_LD, qi0 + 16 * t, 32 * ks, lane), qf[ks], sc[t]); }
        const float ninf = -__builtin_inff();
#pragma unroll
        for (int e = 0; e < 4; ++e) { if (4 * g4 + e < ql) sc[0][e] = ninf; if (4 * g4 + e > ql) sc[8][e] = ninf; }
        if (qblk == 0) {
#pragma unroll
            for (int t = 0; t < 9; ++t)
#pragma unroll
                for (int e = 0; e < 4; ++e) if (qi0 + 16 * t + 4 * g4 + e < 128) sc[t][e] = ninf;
        }
        float m = ninf;
#pragma unroll
        for (int t = 0; t < 9; ++t) m = fmaxf(m, fmaxf(fmaxf(sc[t][0], sc[t][1]), fmaxf(sc[t][2], sc[t][3])));
        m = fmaxf(m, __shfl_xor(m, 16)); m = fmaxf(m, __shfl_xor(m, 32));
        float l = 0.f;
#pragma unroll
        for (int t = 0; t < 9; ++t)
#pragma unroll
            for (int e = 0; e < 4; ++e) { const float p = fast_exp2(sc[t][e] - m); sc[t][e] = p; l += p; }
        l += __shfl_xor(l, 16); l += __shfl_xor(l, 32);
        f32x4 o[4];
#pragma unroll
        for (int dt = 0; dt < 4; ++dt) o[dt] = (f32x4){0.f, 0.f, 0.f, 0.f};
        const f32x4 zero4 = {0.f, 0.f, 0.f, 0.f};
#pragma unroll
        for (int pr = 0; pr < 5; ++pr) { const bf16x8 pf = pack8(sc[2 * pr], pr < 4 ? sc[2 * pr + 1] : zero4);
#pragma unroll
            for (int dt = 0; dt < 4; ++dt) o[dt] = MFMA16(frag_tr2(lds + AT_VOFF, AT_LD, qi0 + 32 * pr, qi0 + 32 * pr + 16, 16 * dt, lane), pf, o[dt]); }
        const float il = 1.0f / l;
        bf16* OP = (bf16*)(F.ws + WS_OPART) + ((size_t)di * MP + qrow) * AW + h * AD; float* ML = (float*)(F.ws + WS_ML) + (((size_t)di * MP + qrow) * AH + h) * 2;
#pragma unroll
        for (int dt = 0; dt < 4; ++dt) { v2u w; w.x = pg8::cvt_pk_bf16(o[dt][0] * il, o[dt][1] * il); w.y = pg8::cvt_pk_bf16(o[dt][2] * il, o[dt][3] * il); *(GAS v2u*)(OP + 16 * dt + 4 * g4) = w; }
        if (g4 == 0) { ML[0] = m; ML[1] = l; }
    }
}

constexpr int SX_LD = 528, SB_LD = 272;
template <class Emit> __device__ __forceinline__ void conv16(const Frame& F, int b, int c, int l0, int xch, const Emit& emit) {
    const bf16* XBC = (const bf16*)(F.ws + WS_XBC);
    float w[4][8], bias[8];
#pragma unroll
    for (int t = 0; t < 4; ++t) { const f32x4 a = *(const GAS f32x4*)(F.convw + t * CONVD + xch), bb = *(const GAS f32x4*)(F.convw + t * CONVD + xch + 4);
        w[t][0] = a.x; w[t][1] = a.y; w[t][2] = a.z; w[t][3] = a.w; w[t][4] = bb.x; w[t][5] = bb.y; w[t][6] = bb.z; w[t][7] = bb.w; }
    { const f32x4 a = *(const GAS f32x4*)(F.convb + xch), bb = *(const GAS f32x4*)(F.convb + xch + 4); bias[0] = a.x; bias[1] = a.y; bias[2] = a.z; bias[3] = a.w; bias[4] = bb.x; bias[5] = bb.y; bias[6] = bb.z; bias[7] = bb.w; }
    const int s0 = c * LCH + l0;
    const bf16* base = XBC + ((size_t)b * SEQ + s0) * CONVD + xch;
    v4u win[3];
#pragma unroll
    for (int t = 0; t < 3; ++t) { win[t] = (v4u){0u, 0u, 0u, 0u}; if (s0 - 3 + t >= 0) win[t] = *(const GAS v4u*)(base + (ptrdiff_t)(t - 3) * CONVD); }
#pragma unroll 4
    for (int i = 0; i < 16; ++i) {
        const v4u cur = *(const GAS v4u*)(base + (size_t)i * CONVD);
        float y[8];
#pragma unroll
        for (int e = 0; e < 8; ++e) {
            const unsigned x0 = win[0][e >> 1], x1 = win[1][e >> 1], x2 = win[2][e >> 1], x3 = cur[e >> 1];
            const float f0 = (e & 1) ? __uint_as_float(x0 & 0xffff0000u) : __uint_as_float(x0 << 16), f1 = (e & 1) ? __uint_as_float(x1 & 0xffff0000u) : __uint_as_float(x1 << 16);
            const float f2 = (e & 1) ? __uint_as_float(x2 & 0xffff0000u) : __uint_as_float(x2 << 16), f3 = (e & 1) ? __uint_as_float(x3 & 0xffff0000u) : __uint_as_float(x3 << 16);
            y[e] = silu_f(bias[e] + f0 * w[0][e] + f1 * w[1][e] + f2 * w[2][e] + f3 * w[3][e]);
        }
        emit(l0 + i, y);
        win[0] = win[1]; win[1] = win[2]; win[2] = cur;
    }
}
__device__ __forceinline__ void st8_lds(LAS unsigned char* p, const float (&y)[8]) { v4u w; w.x = pg8::cvt_pk_bf16(y[0], y[1]); w.y = pg8::cvt_pk_bf16(y[2], y[3]); w.z = pg8::cvt_pk_bf16(y[4], y[5]); w.w = pg8::cvt_pk_bf16(y[6], y[7]); *(LAS v4u*)p = w; }

constexpr int P2S_X = 0, P2S_B = 128 * SX_LD, P2S_CS = P2S_B + 128 * SB_LD, P2S_F = P2S_CS + 2048;
__device__ __forceinline__ void ssd_state_unit(Frame& F, int u) {
    const int b = u >> 7, c = (u >> 2) & 31, g = u & 3;
    LAS unsigned char* lds = F.lds; const int lane = F.lane, wave = F.wave;
    LAS float* csT = (LAS float*)(lds + P2S_CS); LAS float* fT = (LAS float*)(lds + P2S_F);
    __syncthreads();
    if (wave < 4) {
        const int h = 4 * g + wave; const float a = -__expf(F.alog[h]);
        const float* dtp = (const float*)(F.ws + WS_DT) + ((size_t)b * SEQ + c * LCH + 2 * lane) * 16 + h;
        const float d0 = dtp[0], d1 = dtp[16]; const float a0 = d0 * a, a1 = d1 * a;
        float s = a0 + a1;
#pragma unroll
        for (int o = 1; o < 64; o <<= 1) { const float t = __shfl_up(s, o); if (lane >= o) s += t; }
        const float tot = __shfl(s, 63); const float c1 = s, c0 = s - a1;
        csT[wave * 128 + 2 * lane] = c0; csT[wave * 128 + 2 * lane + 1] = c1;
        fT[(2 * lane) * 4 + wave] = d0 * __expf(tot - c0); fT[(2 * lane + 1) * 4 + wave] = d1 * __expf(tot - c1);
        float* CS = (float*)(F.ws + WS_CSUM) + (((size_t)b * NCH + c) * NHS + h) * LCH;
        *(GAS f32x2*)(CS + 2 * lane) = (f32x2){c0, c1};
        if (lane == 0) ((float*)(F.ws + WS_CDEC))[((size_t)b * NCH + c) * NHS + h] = __expf(tot);
    }
    __syncthreads();
    if (F.tid < 384) {
        const int cg = F.tid % 48, seg = F.tid / 48;
        const int xch = cg < 32 ? 256 * g + 8 * cg : 1024 + 128 * g + 8 * (cg - 32);
        conv16(F, b, c, 16 * seg, xch, [&](int l, float (&y)[8]) {
            if (cg < 32) { const float f = fT[l * 4 + (cg >> 3)];
#pragma unroll
                for (int e = 0; e < 8; ++e) y[e] *= f;
                st8_lds(lds + P2S_X + l * SX_LD + cg * 16, y); }
            else st8_lds(lds + P2S_B + l * SB_LD + (cg - 32) * 16, y);
        });
    }
    __syncthreads();
    f32x4 acc[2][8];
#pragma unroll
    for (int mt = 0; mt < 2; ++mt)
#pragma unroll
        for (int nt = 0; nt < 8; ++nt) acc[mt][nt] = (f32x4){0.f, 0.f, 0.f, 0.f};
#pragma unroll
    for (int ks = 0; ks < 4; ++ks) {
        bf16x8 af[2];
#pragma unroll
        for (int mt = 0; mt < 2; ++mt) af[mt] = frag_tr(lds + P2S_X, SX_LD, 32 * ks, 32 * wave + 16 * mt, lane);
#pragma unroll
        for (int nt = 0; nt < 8; ++nt) { const bf16x8 bfr = frag_tr(lds + P2S_B, SB_LD, 32 * ks, 16 * nt, lane);
#pragma unroll
            for (int mt = 0; mt < 2; ++mt) acc[mt][nt] = MFMA16(af[mt], bfr, acc[mt][nt]); }
    }
    float* STL = (float*)(F.ws + WS_STL) + (((size_t)b * NCH + c) * NHS + 4 * g) * (PH * NST);
#pragma unroll
    for (int mt = 0; mt < 2; ++mt)
#pragma unroll
        for (int e = 0; e < 4; ++e) { const int ch = 32 * wave + 16 * mt + 4 * (lane >> 4) + e;
#pragma unroll
            for (int nt = 0; nt < 8; ++nt) STL[(size_t)ch * NST + 16 * nt + (lane & 15)] = acc[mt][nt][e]; }
}

__device__ __forceinline__ void p3_recurrence(Frame& F) {
    const int gt = F.vcu * (NWAVES * 64) + F.tid, NGT = F.G * NWAVES * 64;
    for (int it = gt; it < NB * NHS * PH * NST / 8; it += NGT) {
        const int n8 = it & 15, p = (it >> 4) & 63, h = (it >> 10) & 15, b = it >> 14;
        float st[8];
#pragma unroll
        for (int e = 0; e < 8; ++e) st[e] = 0.f;
        const size_t eoff = (size_t)p * NST + 8 * n8;
#pragma unroll 4
        for (int c = 0; c < NCH; ++c) {
            const size_t base = (((size_t)b * NCH + c) * NHS + h) * (PH * NST) + eoff;
            const f32x4 l0 = *(const GAS f32x4*)((const float*)(F.ws + WS_STL) + base), l1 = *(const GAS f32x4*)((const float*)(F.ws + WS_STL) + base + 4);
            const float dec = ((const float*)(F.ws + WS_CDEC))[((size_t)b * NCH + c) * NHS + h];
            v4u w; w.x = pg8::cvt_pk_bf16(st[0], st[1]); w.y = pg8::cvt_pk_bf16(st[2], st[3]); w.z = pg8::cvt_pk_bf16(st[4], st[5]); w.w = pg8::cvt_pk_bf16(st[6], st[7]);
            *(GAS v4u*)((bf16*)(F.ws + WS_SPREV) + base) = w;
            st[0] = st[0] * dec + l0.x; st[1] = st[1] * dec + l0.y; st[2] = st[2] * dec + l0.z; st[3] = st[3] * dec + l0.w;
            st[4] = st[4] * dec + l1.x; st[5] = st[5] * dec + l1.y; st[6] = st[6] * dec + l1.z; st[7] = st[7] * dec + l1.w;
        }
        float* o = F.out + O_SSP + (((size_t)b * NHS + h) * PH + p) * NST + 8 * n8;
        *(GAS f32x4*)o = (f32x4){st[0], st[1], st[2], st[3]}; *(GAS f32x4*)(o + 4) = (f32x4){st[4], st[5], st[6], st[7]};
    }
}

constexpr int CR_LD = 272, CR_VOFF = 256 * CR_LD;
__device__ __forceinline__ void cross_group(Frame& F, int gidx) {
    const int bhc = gidx >> 3, b = bhc >> 2, hc = bhc & 3, qb0 = (gidx & 7) * 4;
    LAS unsigned char* lds = F.lds; const int lane = F.lane, g4 = lane >> 4, ql = lane & 15;
    const bf16* MK = (const bf16*)(F.ws + WS_MK); const bf16* MV = (const bf16*)(F.ws + WS_MV);
    __syncthreads();
    for (int idx = F.tid; idx < 256 * 16; idx += NWAVES * 64) { const int row = idx >> 4, ch = idx & 15; const size_t g = ((size_t)b * MEML + row) * 512 + hc * CD + ch * 8;
        *(LAS v4u*)(lds + row * CR_LD + ch * 16) = *(const GAS v4u*)(MK + g); *(LAS v4u*)(lds + CR_VOFF + row * CR_LD + ch * 16) = *(const GAS v4u*)(MV + g); }
    __syncthreads();
    const bf16* QC = (const bf16*)(F.ws + WS_QC); const bf16* GC = (const bf16*)(F.ws + WS_GC); bf16* CAT = (bf16*)(F.ws + WS_CAT);
#pragma unroll 1
    for (int qi = 0; qi < 4; ++qi) {
        const size_t qrow = (size_t)b * SEQ + (qb0 + qi) * 128 + 16 * F.wave + ql;
        bf16x8 qf[4];
#pragma unroll
        for (int ks = 0; ks < 4; ++ks) qf[ks] = *(const GAS bf16x8*)(QC + qrow * 512 + hc * CD + 32 * ks + 8 * g4);
        f32x4 sc[16];
#pragma unroll
        for (int t = 0; t < 16; ++t) { sc[t] = (f32x4){0.f, 0.f, 0.f, 0.f};
#pragma unroll
            for (int ks = 0; ks < 4; ++ks) sc[t] = MFMA16(frag_row(lds, CR_LD, 16 * t, 32 * ks, lane), qf[ks], sc[t]); }
        float m = -__builtin_inff();
#pragma unroll
        for (int t = 0; t < 16; ++t) m = fmaxf(m, fmaxf(fmaxf(sc[t][0], sc[t][1]), fmaxf(sc[t][2], sc[t][3])));
        m = fmaxf(m, __shfl_xor(m, 16)); m = fmaxf(m, __shfl_xor(m, 32));
        float l = 0.f;
#pragma unroll
        for (int t = 0; t < 16; ++t)
#pragma unroll
            for (int e = 0; e < 4; ++e) { const float p = fast_exp2(sc[t][e] - m); sc[t][e] = p; l += p; }
        l += __shfl_xor(l, 16); l += __shfl_xor(l, 32);
        f32x4 o[8];
#pragma unroll
        for (int dt = 0; dt < 8; ++dt) o[dt] = (f32x4){0.f, 0.f, 0.f, 0.f};
#pragma unroll
        for (int pr = 0; pr < 8; ++pr) { const bf16x8 pf = pack8(sc[2 * pr], sc[2 * pr + 1]);
#pragma unroll
            for (int dt = 0; dt < 8; ++dt) o[dt] = MFMA16(frag_tr2(lds + CR_VOFF, CR_LD, 32 * pr, 32 * pr + 16, 16 * dt, lane), pf, o[dt]); }
        const float il = 1.0f / l;
#pragma unroll
        for (int dt = 0; dt < 8; ++dt) { const v2u gv = *(const GAS v2u*)(GC + qrow * 512 + hc * CD + 16 * dt + 4 * g4);
            const float g0 = __uint_as_float(gv.x << 16), g1 = __uint_as_float(gv.x & 0xffff0000u), g2 = __uint_as_float(gv.y << 16), g3 = __uint_as_float(gv.y & 0xffff0000u);
            v2u w; w.x = pg8::cvt_pk_bf16(o[dt][0] * il * g0, o[dt][1] * il * g1); w.y = pg8::cvt_pk_bf16(o[dt][2] * il * g2, o[dt][3] * il * g3);
            *(GAS v2u*)(CAT + qrow * 2048 + 1536 + hc * CD + 16 * dt + 4 * g4) = w; }
    }
}

__device__ __forceinline__ f32x4 conv_sample4(const Frame& F, int i, int ch) {
    f32x4 y = *(const GAS f32x4*)(F.convb + ch);
#pragma unroll
    for (int t = 0; t < 3; ++t) y += *(const GAS f32x4*)(F.sconv + ((size_t)i * 3 + t) * CONVD + ch) * *(const GAS f32x4*)(F.convw + t * CONVD + ch);
    y += *(const GAS f32x4*)(F.out + O_CVS + ((size_t)i * 3 + 2) * CONVD + ch) * *(const GAS f32x4*)(F.convw + 3 * CONVD + ch);
    return silu4(y);
}
__device__ __forceinline__ void smp_ssd_item(Frame& F, int item) {
    const int i = item >> 4, h = item & 15, g = h >> 2, lane = F.lane, half = lane >> 5, l32 = lane & 31;
    const float dt = ((const float*)(F.ws + WS_DT))[((size_t)MP + i) * 16 + h];
    const float dA = __expf(-dt * __expf(F.alog[h]));
    const float dsk = F.dskip[h];
    const f32x4 xv4 = conv_sample4(F, i, h * 64 + (lane & ~3)); const float xv = (lane & 3) == 0 ? xv4.x : (lane & 3) == 1 ? xv4.y : (lane & 3) == 2 ? xv4.z : xv4.w;
    const f32x4 Bv = conv_sample4(F, i, 1024 + g * 128 + 4 * l32), Cv = conv_sample4(F, i, 1536 + g * 128 + 4 * l32);
    const float* S0 = F.sssm + ((size_t)i * NHS + h) * (PH * NST); float* S1 = F.out + O_SSS + ((size_t)i * NHS + h) * (PH * NST);
    float yacc = 0.f;
#pragma unroll 4
    for (int ps = 0; ps < 32; ++ps) {
        const int p = 2 * ps + half; const float xp = __shfl(xv, p) * dt;
        f32x4 s = *(const GAS f32x4*)(S0 + (size_t)p * NST + 4 * l32);
        s = s * dA + Bv * xp;
        *(GAS f32x4*)(S1 + (size_t)p * NST + 4 * l32) = s;
        float d = (s.x * Cv.x + s.y * Cv.y) + (s.z * Cv.z + s.w * Cv.w);
#pragma unroll
        for (int o = 1; o < 32; o <<= 1) d += __shfl_xor(d, o);
        const float d0 = __shfl(d, 0), d1 = __shfl(d, 32);
        if (lane == 2 * ps) yacc = d0; if (lane == 2 * ps + 1) yacc = d1;
    }
    ((float*)(F.ws + WS_SMP))[(size_t)i * 1024 + h * 64 + lane] = yacc + xv * dsk;
}
__device__ __forceinline__ void smp_att_item(Frame& F, int item) {
    const int i = item >> 3, h = item & 7, lane = F.lane, slot = lane >> 4, dl = lane & 15;
    const v2u qv = *(const GAS v2u*)((const bf16*)(F.ws + WS_Q) + ((size_t)MP + i) * AW + h * AD + 4 * dl);
    const f32x4 q = {__uint_as_float(qv.x << 16), __uint_as_float(qv.x & 0xffff0000u), __uint_as_float(qv.y << 16), __uint_as_float(qv.y & 0xffff0000u)};
    const float* kc = F.cwk + ((size_t)i * WBUF * AH + h) * AD + 4 * dl; const float* vc = F.cwv + ((size_t)i * WBUF * AH + h) * AD + 4 * dl;
    const float* kn = F.out + O_WKS + (size_t)i * AW + h * AD + 4 * dl; const float* vn = F.out + O_WVS + (size_t)i * AW + h * AD + 4 * dl;
    float m = -__builtin_inff(), l = 0.f; f32x4 acc = {0.f, 0.f, 0.f, 0.f};
#pragma unroll 1
    for (int di = 0; di < 3; ++di) {
        const int dil = di == 0 ? 1 : (di == 1 ? 4 : 16);
#pragma unroll 3
        for (int ps = 0; ps < 33; ++ps) {
            const int j = 4 * ps + slot; const bool valid = j < 129;
            const int row = valid ? WBUF - dil * j : 0;
            const float* kp = kc + (size_t)row * (AH * AD); const float* vp = vc + (size_t)row * (AH * AD);
            if (j == 0) { kp = kn; vp = vn; }
            const f32x4 kv = *(const GAS f32x4*)kp, vv = *(const GAS f32x4*)vp;
            float s = (q.x * kv.x + q.y * kv.y) + (q.z * kv.z + q.w * kv.w);
#pragma unroll
            for (int o = 1; o < 16; o <<= 1) s += __shfl_xor(s, o);
            if (!valid) s = -__builtin_inff();
            const float mn = fmaxf(m, s);
            if (mn > -__builtin_inff()) { const float al = fast_exp2(m - mn), p = fast_exp2(s - mn); l = l * al + p; acc = acc * al + vv * p; m = mn; }
        }
    }
    float M = fmaxf(m, __shfl_xor(m, 16)); M = fmaxf(M, __shfl_xor(M, 32));
    const float sc = fast_exp2(m - M); l *= sc; acc = acc * sc;
    l += __shfl_xor(l, 16); l += __shfl_xor(l, 32);
#pragma unroll
    for (int e = 0; e < 4; ++e) { float a = acc[e]; a += __shfl_xor(a, 16); a += __shfl_xor(a, 32); acc[e] = a; }
    if (slot == 0) *(GAS f32x4*)((float*)(F.ws + WS_SMP) + 128 * 1024 + (size_t)i * AW + h * AD + 4 * dl) = acc * (1.0f / l);
}
__device__ __forceinline__ void smp_cross_item(Frame& F, int item) {
    const int i = item >> 2, hc = item & 3, lane = F.lane, slot = lane >> 5, dl = lane & 31;
    const v2u qv = *(const GAS v2u*)((const bf16*)(F.ws + WS_QC) + ((size_t)MP + i) * 512 + hc * CD + 4 * dl);
    const f32x4 q = {__uint_as_float(qv.x << 16), __uint_as_float(qv.x & 0xffff0000u), __uint_as_float(qv.y << 16), __uint_as_float(qv.y & 0xffff0000u)};
    const float* kc = F.cmk + ((size_t)i * MEML * CH_ + hc) * CD + 4 * dl; const float* vc = F.cmv + ((size_t)i * MEML * CH_ + hc) * CD + 4 * dl;
    float m = -__builtin_inff(), l = 0.f; f32x4 acc = {0.f, 0.f, 0.f, 0.f};
#pragma unroll 4
    for (int ps = 0; ps < 128; ++ps) {
        const int row = 2 * ps + slot;
        const f32x4 kv = *(const GAS f32x4*)(kc + (size_t)row * (CH_ * CD)), vv = *(const GAS f32x4*)(vc + (size_t)row * (CH_ * CD));
        float s = (q.x * kv.x + q.y * kv.y) + (q.z * kv.z + q.w * kv.w);
#pragma unroll
        for (int o = 1; o < 32; o <<= 1) s += __shfl_xor(s, o);
        const float mn = fmaxf(m, s); const float al = fast_exp2(m - mn), p = fast_exp2(s - mn); l = l * al + p; acc = acc * al + vv * p; m = mn;
    }
    const float M = fmaxf(m, __shfl_xor(m, 32));
    const float sc = fast_exp2(m - M); l *= sc; acc = acc * sc;
    l += __shfl_xor(l, 32);
#pragma unroll
    for (int e = 0; e < 4; ++e) acc[e] += __shfl_xor(acc[e], 32);
    if (slot == 0) *(GAS f32x4*)((float*)(F.ws + WS_SMP) + 128 * 1024 + 128 * 512 + (size_t)i * 512 + hc * CD + 4 * dl) = acc * (1.0f / l);
}

constexpr int P4_C = 0, P4_B = 128 * SB_LD, P4_X = 2 * 128 * SB_LD, P4_CS = P4_X + 128 * SX_LD, P4_DT = P4_CS + 2048, P4_END = P4_DT + 2048;
static_assert(P4_END <= SCR_BYTES, "P4 LDS");
__device__ __forceinline__ void ssd_out_unit(Frame& F, int u) {
    const int b = u >> 7, c = (u >> 2) & 31, g = u & 3;
    LAS unsigned char* lds = F.lds; const int lane = F.lane, wave = F.wave, g4 = lane >> 4, ql = lane & 15;
    LAS float* csT = (LAS float*)(lds + P4_CS); LAS float* dtT = (LAS float*)(lds + P4_DT);
    __syncthreads();
    { const int hh = F.tid >> 7, l = F.tid & 127;
      csT[F.tid] = ((const float*)(F.ws + WS_CSUM))[(((size_t)b * NCH + c) * NHS + 4 * g + hh) * LCH + l];
      dtT[F.tid] = ((const float*)(F.ws + WS_DT))[((size_t)b * SEQ + c * LCH + l) * 16 + 4 * g + hh]; }
    { const int cg = F.tid & 63, seg = F.tid >> 6;
      const int xch = cg < 32 ? 256 * g + 8 * cg : (cg < 48 ? 1024 + 128 * g + 8 * (cg - 32) : 1536 + 128 * g + 8 * (cg - 48));
      LAS unsigned char* dst = cg < 32 ? lds + P4_X + cg * 16 : (cg < 48 ? lds + P4_B + (cg - 32) * 16 : lds + P4_C + (cg - 48) * 16);
      const int ld = cg < 32 ? SX_LD : SB_LD;
      conv16(F, b, c, 16 * seg, xch, [&](int l, float (&y)[8]) { st8_lds(dst + l * ld, y); }); }
    __syncthreads();
    bf16x8 cf[4];
#pragma unroll
    for (int ks = 0; ks < 4; ++ks) cf[ks] = frag_row(lds + P4_C, SB_LD, 16 * wave, 32 * ks, lane);
    f32x4 cb[8];
#pragma unroll
    for (int st = 0; st < 8; ++st) { cb[st] = (f32x4){0.f, 0.f, 0.f, 0.f};
        if (st <= wave) {
#pragma unroll
            for (int ks = 0; ks < 4; ++ks) cb[st] = MFMA16(frag_row(lds + P4_B, SB_LD, 16 * st, 32 * ks, lane), cf[ks], cb[st]); } }
    f32x4 y[4][4];
    const int lrow = 16 * wave + ql;
    const bf16* SP = (const bf16*)(F.ws + WS_SPREV) + (((size_t)b * NCH + c) * NHS + 4 * g) * (PH * NST);
#pragma unroll
    for (int hh = 0; hh < 4; ++hh) {
        const float csl = csT[hh * 128 + lrow];
#pragma unroll
        for (int pt = 0; pt < 4; ++pt) { f32x4 a = {0.f, 0.f, 0.f, 0.f};
#pragma unroll
            for (int ks = 0; ks < 4; ++ks) { const bf16x8 sf = *(const GAS bf16x8*)(SP + ((size_t)hh * PH + 16 * pt + ql) * NST + 32 * ks + 8 * g4); a = MFMA16(sf, cf[ks], a); }
            y[hh][pt] = a * __expf(csl); }
#pragma unroll
        for (int pr = 0; pr < 4; ++pr) {
            if (2 * pr <= wave) {
                f32x4 m0, m1;
                { const int s0 = 32 * pr + 4 * g4; const f32x4 css = *(const LAS f32x4*)(csT + hh * 128 + s0), dts = *(const LAS f32x4*)(dtT + hh * 128 + s0);
#pragma unroll
                  for (int e = 0; e < 4; ++e) m0[e] = (s0 + e <= lrow) ? cb[2 * pr][e] * __expf(csl - css[e]) * dts[e] : 0.f; }
                { const int s0 = 32 * pr + 16 + 4 * g4; const f32x4 css = *(const LAS f32x4*)(csT + hh * 128 + s0), dts = *(const LAS f32x4*)(dtT + hh * 128 + s0);
#pragma unroll
                  for (int e = 0; e < 4; ++e) m1[e] = (s0 + e <= lrow) ? cb[2 * pr + 1][e] * __expf(csl - css[e]) * dts[e] : 0.f; }
                const bf16x8 mf = pack8(m0, m1);
#pragma unroll
                for (int pt = 0; pt < 4; ++pt) y[hh][pt] = MFMA16(frag_tr2(lds + P4_X, SX_LD, 32 * pr, 32 * pr + 16, 64 * hh + 16 * pt, lane), mf, y[hh][pt]);
            }
        }
        const float dsk = F.dskip[4 * g + hh];
#pragma unroll
        for (int pt = 0; pt < 4; ++pt) { const v2u xv = *(const LAS v2u*)(lds + P4_X + lrow * SX_LD + (64 * hh + 16 * pt + 4 * g4) * 2);
            y[hh][pt][0] += dsk * __uint_as_float(xv.x << 16); y[hh][pt][1] += dsk * __uint_as_float(xv.x & 0xffff0000u);
            y[hh][pt][2] += dsk * __uint_as_float(xv.y << 16); y[hh][pt][3] += dsk * __uint_as_float(xv.y & 0xffff0000u); }
    }
    __syncthreads();
#pragma unroll
    for (int hh = 0; hh < 4; ++hh)
#pragma unroll
        for (int pt = 0; pt < 4; ++pt) { v2u w; w.x = pg8::cvt_pk_bf16(y[hh][pt][0], y[hh][pt][1]); w.y = pg8::cvt_pk_bf16(y[hh][pt][2], y[hh][pt][3]);
            *(LAS v2u*)(lds + P4_X + lrow * SX_LD + (64 * hh + 16 * pt + 4 * g4) * 2) = w; }
    __syncthreads();
    const bf16* SZ = (const bf16*)(F.ws + WS_SZ); bf16* CAT = (bf16*)(F.ws + WS_CAT);
    const f32x4 gain = *(const GAS f32x4*)(F.ssdg + 256 * g + 4 * lane);
#pragma unroll 4
    for (int i = 0; i < 16; ++i) {
        const int l = 16 * wave + i; const size_t grow = (size_t)b * SEQ + c * LCH + l;
        const v2u yv = *(const LAS v2u*)(lds + P4_X + l * SX_LD + lane * 8); const v2u zv = *(const GAS v2u*)(SZ + grow * DM + 256 * g + 4 * lane);
        const float v0 = __uint_as_float(yv.x << 16) * __uint_as_float(zv.x << 16), v1 = __uint_as_float(yv.x & 0xffff0000u) * __uint_as_float(zv.x & 0xffff0000u);
        const float v2 = __uint_as_float(yv.y << 16) * __uint_as_float(zv.y << 16), v3 = __uint_as_float(yv.y & 0xffff0000u) * __uint_as_float(zv.y & 0xffff0000u);
        const float ss = wave_sum((v0 * v0 + v1 * v1) + (v2 * v2 + v3 * v3));
        const float rs = 1.0f / sqrtf(ss * (1.0f / 256.0f) + EPS);
        v2u w; w.x = pg8::cvt_pk_bf16(v0 * rs * gain.x, v1 * rs * gain.y); w.y = pg8::cvt_pk_bf16(v2 * rs * gain.z, v3 * rs * gain.w);
        *(GAS v2u*)(CAT + grow * 2048 + 256 * g + 4 * lane) = w;
    }
}
__device__ __forceinline__ void combine_row(Frame& F, int row) {
    const int lane = F.lane, hh = lane >> 3;
    const bf16* OP = (const bf16*)(F.ws + WS_OPART); const float* ML = (const float*)(F.ws + WS_ML);
    float m[3], l[3]; v4u o[3];
#pragma unroll
    for (int di = 0; di < 3; ++di) { const f32x2 ml = *(const GAS f32x2*)(ML + (((size_t)di * MP + row) * AH + hh) * 2); m[di] = ml.x; l[di] = ml.y; o[di] = *(const GAS v4u*)(OP + ((size_t)di * MP + row) * AW + 8 * lane); }
    const v4u gv = *(const GAS v4u*)((const bf16*)(F.ws + WS_GA) + (size_t)row * AW + 8 * lane);
    const float M = fmaxf(m[0], fmaxf(m[1], m[2]));
    float wgt[3], den = 0.f;
#pragma unroll
    for (int di = 0; di < 3; ++di) { wgt[di] = fast_exp2(m[di] - M) * l[di]; den += wgt[di]; }
    const float id = 1.0f / den; float r[8];
#pragma unroll
    for (int e = 0; e < 8; ++e) { float a = 0.f;
#pragma unroll
        for (int di = 0; di < 3; ++di) { const unsigned x = o[di][e >> 1]; a += wgt[di] * ((e & 1) ? __uint_as_float(x & 0xffff0000u) : __uint_as_float(x << 16)); }
        const unsigned gx = gv[e >> 1]; r[e] = a * id * ((e & 1) ? __uint_as_float(gx & 0xffff0000u) : __uint_as_float(gx << 16)); }
    v4u w; w.x = pg8::cvt_pk_bf16(r[0], r[1]); w.y = pg8::cvt_pk_bf16(r[2], r[3]); w.z = pg8::cvt_pk_bf16(r[4], r[5]); w.w = pg8::cvt_pk_bf16(r[6], r[7]);
    *(GAS v4u*)((bf16*)(F.ws + WS_CAT) + (size_t)row * 2048 + 1024 + 8 * lane) = w;
}
__device__ __forceinline__ void smp_mix_row(Frame& F, int i) {
    const int lane = F.lane; const size_t row = (size_t)MP + i;
    const float* YS = (const float*)(F.ws + WS_SMP) + (size_t)i * 1024; const float* OA = (const float*)(F.ws + WS_SMP) + 128 * 1024 + (size_t)i * 512; const float* OC = OA + 128 * 512;
    const bf16* SZ = (const bf16*)(F.ws + WS_SZ) + row * DM; bf16* CAT = (bf16*)(F.ws + WS_CAT) + row * 2048;
#pragma unroll
    for (int g = 0; g < 4; ++g) {
        const f32x4 yv = *(const GAS f32x4*)(YS + 256 * g + 4 * lane); const v2u zv = *(const GAS v2u*)(SZ + 256 * g + 4 * lane);
        const float v0 = yv.x * __uint_as_float(zv.x << 16), v1 = yv.y * __uint_as_float(zv.x & 0xffff0000u), v2 = yv.z * __uint_as_float(zv.y << 16), v3 = yv.w * __uint_as_float(zv.y & 0xffff0000u);
        const float ss = wave_sum((v0 * v0 + v1 * v1) + (v2 * v2 + v3 * v3)); const float rs = 1.0f / sqrtf(ss * (1.0f / 256.0f) + EPS);
        const f32x4 gain = *(const GAS f32x4*)(F.ssdg + 256 * g + 4 * lane);
        v2u w; w.x = pg8::cvt_pk_bf16(v0 * rs * gain.x, v1 * rs * gain.y); w.y = pg8::cvt_pk_bf16(v2 * rs * gain.z, v3 * rs * gain.w);
        *(GAS v2u*)(CAT + 256 * g + 4 * lane) = w;
    }
#pragma unroll
    for (int k = 0; k < 2; ++k) {
        const float* O = (k == 0 ? OA : OC) + 8 * lane; const bf16* G = (const bf16*)(F.ws + (k == 0 ? WS_GA : WS_GC)) + row * 512 + 8 * lane;
        const f32x4 a = *(const GAS f32x4*)O, b2 = *(const GAS f32x4*)(O + 4); const v4u gv = *(const GAS v4u*)G;
        v4u w; w.x = pg8::cvt_pk_bf16(a.x * __uint_as_float(gv.x << 16), a.y * __uint_as_float(gv.x & 0xffff0000u)); w.y = pg8::cvt_pk_bf16(a.z * __uint_as_float(gv.y << 16), a.w * __uint_as_float(gv.y & 0xffff0000u));
        w.z = pg8::cvt_pk_bf16(b2.x * __uint_as_float(gv.z << 16), b2.y * __uint_as_float(gv.z & 0xffff0000u)); w.w = pg8::cvt_pk_bf16(b2.z * __uint_as_float(gv.w << 16), b2.w * __uint_as_float(gv.w & 0xffff0000u));
        *(GAS v4u*)(CAT + 1024 + 512 * k + 8 * lane) = w;
    }
}
struct Epi2 {
    static constexpr bool PERM = true, AFTER_DRAIN = false;
    const float* xp; const float* xs; float* out;
    __device__ __forceinline__ void operator()(const pg8::f32x4 (&acc)[2][2][4][2], const pg8::Unit& u, int wr, int wc, int fr, int fq) const {
        const int rbase = u.pm * 256 + wr * 64 + fr, cbase = u.pn * 256 + wc * 32 + 8 * fq;
        if (u.pm < 128) {
#pragma unroll
            for (int ai = 0; ai < 2; ++ai)
#pragma unroll
                for (int m = 0; m < 4; ++m) { const size_t off = (size_t)(rbase + ai * 128 + m * 16) * DM + cbase;
                    f32x4 r0[2], r1[2];
#pragma unroll
                    for (int bj = 0; bj < 2; ++bj) { r0[bj] = *(const GAS f32x4*)(xp + off + bj * 128); r1[bj] = *(const GAS f32x4*)(xp + off + bj * 128 + 4); }
#pragma unroll
                    for (int bj = 0; bj < 2; ++bj) st8_f32(out + O_YP + off + bj * 128, acc[ai][bj][m][0] + r0[bj], acc[ai][bj][m][1] + r1[bj]); }
        } else {
#pragma unroll
            for (int ai = 0; ai < 2; ++ai)
#pragma unroll
                for (int m = 0; m < 4; ++m) { const int row = rbase + ai * 128 + m * 16 - MP;
                    if (row < NS) { const size_t off = (size_t)row * DM + cbase;
#pragma unroll
                        for (int bj = 0; bj < 2; ++bj) st8_f32(out + O_YS + off + bj * 128, acc[ai][bj][m][0] + *(const GAS f32x4*)(xs + off + bj * 128), acc[ai][bj][m][1] + *(const GAS f32x4*)(xs + off + bj * 128 + 4)); } }
        }
    }
};
struct Sched2 {
    int G, c;
    __device__ __forceinline__ bool next(int i, pg8::Unit& u) const {
        constexpr int nM = TM_MAIN, nN = 4, nwg = nM * nN, q = nwg / 8, r = nwg % 8;
        const int L = i * G + c; if (L >= nwg) return false;
        const int xcd = L % 8, off = L / 8; const int wgid = (xcd < r ? xcd * (q + 1) : r * (q + 1) + (xcd - r) * q) + off;
        constexpr int nig = pg8::WGM * nN; const int gid = wgid / nig, fm = gid * pg8::WGM, gsz = (nM - fm) < pg8::WGM ? (nM - fm) : pg8::WGM;
        u.pm = fm + ((wgid % nig) % gsz); u.pn = (wgid % nig) / gsz; return true;
    }
    __device__ __forceinline__ void a_ready(const pg8::Unit&) const {}
    __device__ __forceinline__ void done(const pg8::Unit&) const {}
};
__device__ __forceinline__ void final_norm_row(Frame& F, float* rowp) {
    GAS f32x4* xr = (GAS f32x4*)rowp + F.lane; f32x4 v[4]; float s = 0.f;
#pragma unroll
    for (int j = 0; j < 4; ++j) { v[j] = xr[64 * j]; s += (v[j].x * v[j].x + v[j].y * v[j].y) + (v[j].z * v[j].z + v[j].w * v[j].w); }
    const float rs = 1.0f / sqrtf(wave_sum(s) * (1.0f / DM) + EPS);
#pragma unroll
    for (int j = 0; j < 4; ++j) { const f32x4 gn = *((const GAS f32x4*)F.fng + F.lane + 64 * j); xr[64 * j] = v[j] * rs * gn; }
}

#ifndef MK_N_LAUNCHES
#define MK_N_LAUNCHES 1
#endif
constexpr int N_PHASES = 7;
struct Args { const float *xp, *xs, *mem, *cwk, *cwv, *cmk, *cmv, *sconv, *sssm, *pos, *lng, *win, *convw, *convb, *dtb, *alog, *dskip, *ssdg, *memg, *wmem, *wout, *fng; float* out; unsigned char* ws; int ph_lo, ph_hi, li, pad; };
__global__ void __launch_bounds__(NWAVES * 64, 2) mk_fwd(Args args) {
    extern __shared__ __attribute__((aligned(16))) unsigned char lds[];
    Frame F;
    F.lds = (LAS unsigned char*)lds;
    F.MISC = (volatile LAS unsigned*)(F.lds + MISC_OFF);
    F.tid = threadIdx.x; F.lane = F.tid & 63; F.wave = __builtin_amdgcn_readfirstlane(F.tid >> 6);
    F.G = gridDim.x; { const int bx = blockIdx.x; F.vcu = (F.G % 8 == 0) ? (bx % 8) * (F.G / 8) + bx / 8 : bx; }
    F.ws = args.ws; F.out = args.out; F.ctl = (gu32*)(args.ws + WS_CTL);
    F.xp = args.xp;
    F.xs = args.xs;
    F.mem = args.mem;
    F.cwk = args.cwk;
    F.cwv = args.cwv;
    F.cmk = args.cmk;
    F.cmv = args.cmv;
    F.sconv = args.sconv;
    F.sssm = args.sssm;
    F.pos = args.pos;
    F.lng = args.lng;
    F.win = args.win;
    F.convw = args.convw;
    F.convb = args.convb;
    F.dtb = args.dtb;
    F.alog = args.alog;
    F.dskip = args.dskip;
    F.ssdg = args.ssdg;
    F.memg = args.memg;
    F.wmem = args.wmem;
    F.wout = args.wout;
    F.fng = args.fng;
    if (F.tid < 32) F.MISC[F.tid] = 0u;
    __syncthreads();
    XcdBarrier bar = xcd_barrier_post((unsigned*)(F.ctl + CW_BAR) + args.li * XCD_BAR_WORDS, F.MISC + 8);
    const int lo = args.ph_lo, hi = args.ph_hi;
#ifdef PH_ONLY
#define IN(k) ((k) == PH_ONLY)
#else
#define IN(k) (lo <= (k) && (k) < hi)
#endif
#define SEAM(k) do { if (IN(k) && IN((k) + 1)) xcd_barrier(bar); } while (0)

    if (IN(0)) { p0_prologue(F); __syncthreads(); }
    SEAM(0);
    if (IN(1)) {
        pg8::Gemm g{(const pg8::bf16_t*)(F.ws + WS_XN), (const pg8::bf16_t*)(F.ws + WS_WT), XNR, NTOT, DM};
        Sched1 S{F.G, (int)blockIdx.x};
        Epi1 E{(const float*)(F.ws + WS_RSTD), (const float*)(F.ws + WS_ROPE), F.out, F.ws};
        pg8::gemm_phase<Epi1, Sched1, true, true>(F.lds, g, S, E);
    }
    SEAM(1);
    if (IN(2)) {
#ifndef P2_PARTS
#define P2_PARTS 63
#endif
        if (P2_PARTS & 1) for (int u = F.vcu; u < NB * NCH * NGRP; u += F.G) ssd_state_unit(F, u);
        if (P2_PARTS & 2) for (int u = F.vcu; u < NB * AH * 48; u += F.G) attn_unit(F, u);
        if (P2_PARTS & 4) for (int u = F.vcu; u < 256; u += F.G) cross_group(F, u);
        const int gw = F.vcu * NWAVES + F.wave, NGW = F.G * NWAVES;
        if (P2_PARTS & 8) for (int it = gw; it < NS * NHS; it += NGW) smp_ssd_item(F, it);
        if (P2_PARTS & 16) for (int it = gw; it < NS * AH; it += NGW) smp_att_item(F, it);
        if (P2_PARTS & 32) for (int it = gw; it < NS * CH_; it += NGW) smp_cross_item(F, it);
        { const int gt = F.vcu * (NWAVES * 64) + F.tid, NGT = F.G * NWAVES * 64;
          for (int it = gt; it < NS * 2 * CONVD / 4; it += NGT) { const int i = it / (2 * CONVD / 4), rem = it % (2 * CONVD / 4);
              *(GAS f32x4*)(F.out + O_CVS + (size_t)i * 3 * CONVD + 4 * rem) = *(const GAS f32x4*)(F.sconv + (size_t)i * 3 * CONVD + CONVD + 4 * rem); } }
        __syncthreads();
    }
    SEAM(2);
    if (IN(3)) p3_recurrence(F);
    SEAM(3);
    if (IN(4)) {
        for (int u = F.vcu; u < NB * NCH * NGRP; u += F.G) ssd_out_unit(F, u);
        const int gw = F.vcu * NWAVES + F.wave, NGW = F.G * NWAVES;
        for (int it = gw; it < MP; it += NGW) combine_row(F, it);
        for (int it = gw; it < NS; it += NGW) smp_mix_row(F, it);
        __syncthreads();
    }
    SEAM(4);
    if (IN(5)) {
        pg8::Gemm g{(const pg8::bf16_t*)(F.ws + WS_CAT), (const pg8::bf16_t*)(F.ws + WS_WOT), RTOT, DM, 2048};
        Sched2 S{F.G, (int)blockIdx.x};
        Epi2 E{F.xp, F.xs, F.out};
        pg8::gemm_phase<Epi2, Sched2, true, true>(F.lds, g, S, E);
    }
    SEAM(5);
    if (IN(6)) {
        const int gw = F.vcu * NWAVES + F.wave, NGW = F.G * NWAVES;
        for (int it = gw; it < MP + NS; it += NGW) final_norm_row(F, it < MP ? F.out + O_YP + (size_t)it * DM : F.out + O_YS + (size_t)(it - MP) * DM);
    }
#undef IN
#undef SEAM
}

extern "C" void kernel_launch(void* const* d_in, const int* in_sizes, int n_in, void* d_out, int out_size, void* d_ws, size_t ws_size, hipStream_t stream) {
    static int grid = 0;
    if (grid == 0) {
        if (n_in != N_INPUTS || (size_t)out_size != O_END || ws_size < WS_END) { fprintf(stderr, "kernel_launch: unexpected shapes (n_in %d, out %d, ws %zu); nothing launched\n", n_in, out_size, ws_size); grid = -1; return; }
        int dev = 0, cus = 0, per_cu = 0;
        if (hipGetDevice(&dev) != hipSuccess || hipDeviceGetAttribute(&cus, hipDeviceAttributeMultiprocessorCount, dev) != hipSuccess) { grid = -1; return; }
        if (hipFuncSetAttribute((const void*)mk_fwd, hipFuncAttributeMaxDynamicSharedMemorySize, LDS_BYTES) != hipSuccess) { fprintf(stderr, "kernel_launch: hipFuncSetAttribute failed\n"); grid = -1; return; }
        if (hipOccupancyMaxActiveBlocksPerMultiprocessor(&per_cu, (const void*)mk_fwd, NWAVES * 64, LDS_BYTES) != hipSuccess || per_cu < 1) { fprintf(stderr, "kernel_launch: occupancy query reports %d blocks per CU\n", per_cu); }
        (void)hipGetLastError();
        grid = cus;
    }
    if (grid < 0) return;
    if (hipMemsetAsync((char*)d_ws + WS_CTL, 0, CTL_ZERO_BYTES, stream) != hipSuccess) return;
    Args a{};
    a.xp = (const float*)d_in[I_XP];
    a.xs = (const float*)d_in[I_XS];
    a.mem = (const float*)d_in[I_MEM];
    a.cwk = (const float*)d_in[I_CWK];
    a.cwv = (const float*)d_in[I_CWV];
    a.cmk = (const float*)d_in[I_CMK];
    a.cmv = (const float*)d_in[I_CMV];
    a.sconv = (const float*)d_in[I_SCONV];
    a.sssm = (const float*)d_in[I_SSSM];
    a.pos = (const float*)d_in[I_POS];
    a.lng = (const float*)d_in[I_LNG];
    a.win = (const float*)d_in[I_WIN];
    a.convw = (const float*)d_in[I_CONVW];
    a.convb = (const float*)d_in[I_CONVB];
    a.dtb = (const float*)d_in[I_DTB];
    a.alog = (const float*)d_in[I_ALOG];
    a.dskip = (const float*)d_in[I_DSKIP];
    a.ssdg = (const float*)d_in[I_SSDG];
    a.memg = (const float*)d_in[I_MEMG];
    a.wmem = (const float*)d_in[I_WMEM];
    a.wout = (const float*)d_in[I_WOUT];
    a.fng = (const float*)d_in[I_FNG];
    a.out = (float*)d_out; a.ws = (unsigned char*)d_ws;
    if (MK_N_LAUNCHES == 1) { a.ph_lo = 0; a.ph_hi = N_PHASES; a.li = 0; hipLaunchKernelGGL(mk_fwd, dim3(grid), dim3(NWAVES * 64), LDS_BYTES, stream, a); }
    else for (int li = 0; li < N_PHASES; ++li) { a.ph_lo = li; a.ph_hi = li + 1; a.li = li; hipLaunchKernelGGL(mk_fwd, dim3(grid), dim3(NWAVES * 64), LDS_BYTES, stream, a); }
}
```

```cpp
#include <hip/hip_runtime.h>
#include <cstdio>
#include <cstdint>
#include <cmath>
namespace pg8 {
#define PG8_LAS __attribute__((address_space(3)))
typedef unsigned short bf16_t;
typedef short bf16x8 __attribute__((ext_vector_type(8)));
typedef float f32x4 __attribute__((ext_vector_type(4)));
typedef unsigned u32x4 __attribute__((ext_vector_type(4)));
constexpr int BM = 256, BK = 64, HALF = 128, HTB = HALF * BK * 2  , STAGE_BYTES = 8 * HTB, NXCD = 8, WGM = 8;

__host__ __device__ __forceinline__ int lds_byte(int r, int c) { const int st = (r >> 4) * 2 + (c >> 5), rr = r & 15, cc = c & 31, ob = rr * 64 + cc * 2; return st * 1024 + (ob ^ (((ob >> 9) & 1) << 5)); }
__host__ __device__ __forceinline__ void stage_rc(int b, int& R, int& C) { const int st = b / 1024, sb = b % 1024, swz = sb ^ (((sb >> 9) & 1) << 5); R = (st >> 1) * 16 + swz / 64; C = (st & 1) * 32 + (swz % 64) / 2; }
__host__ __device__ __forceinline__ int perm32(int rho) { const int n = rho >> 4, i = rho & 15; return 8 * (i >> 2) + 4 * n + (i & 3); }

struct Unit { int pm, pn; };
struct Gemm { const bf16_t* A; const bf16_t* Bt; int M, N, K; };

struct StaticOrder {
    int nM, nN, nwg, G, c;
    __host__ __device__ void init(int M, int N, int G_, int c_) { nM = M / BM; nN = N / BM; nwg = nM * nN; G = G_; c = c_; }
    __host__ __device__ bool next(int i, Unit& u) const {
        const long L = (long)i * G + c; if (L >= nwg) return false;
        int wgid = (int)L; { const int q = nwg / NXCD, r = nwg % NXCD, xcd = wgid % NXCD, off = wgid / NXCD; wgid = (xcd < r ? xcd * (q + 1) : r * (q + 1) + (xcd - r) * q) + off; }
        const int nig = WGM * nN, gid = wgid / nig, fm = gid * WGM, gsz = (nM - fm) < WGM ? (nM - fm) : WGM;
        u.pm = fm + ((wgid % nig) % gsz); u.pn = (wgid % nig) / gsz; return true;
    }
    __device__ __forceinline__ void a_ready(const Unit&) const {}
    __device__ __forceinline__ void done(const Unit&) const {}
};
__device__ __forceinline__ unsigned cvt_pk_bf16(float lo, float hi) { unsigned r; asm volatile("v_cvt_pk_bf16_f32 %0, %1, %2" : "=v"(r) : "v"(lo), "v"(hi)); return r; }
typedef float f32x2 __attribute__((ext_vector_type(2)));
template <class Epi, class Sched, bool ALIGN_EPI = false, bool SP2 = false>
__device__ __forceinline__ void gemm_phase(PG8_LAS unsigned char* lds, const Gemm g, const Sched& S, const Epi& E) {
    const int tid = threadIdx.x, wid = __builtin_amdgcn_readfirstlane(tid >> 6), lane = tid & 63, wr = wid >> 2, wc = wid & 3, fr = lane & 15, fq = lane >> 4;
    const int K = g.K, nt = K / BK;
    unsigned voffA[2], voffB[2];
#pragma unroll
    for (int i = 0; i < 2; ++i) { int R, C; stage_rc(tid * 16 + i * 8192, R, C); const int Rb = Epi::PERM ? ((R & ~31) + perm32(R & 31)) : R;
        voffA[i] = (unsigned)(R * K + C) * 2u; voffB[i] = (unsigned)(Rb * K + C) * 2u; }
    const size_t kstep = (size_t)(BK * 2);
    const size_t hstep = (size_t)HALF * K * 2;
    const size_t tstep = 2 * hstep;
    const unsigned ldsw = (unsigned)wid * 1024u;
    const int aoff = lds_byte(wr * 64 + fr, fq * 8), boff = lds_byte(wc * 32 + fr, fq * 8);
#define PG8_SA(b, h) (((b) * 2 + (h)) * HTB)
#define PG8_SB(b, h) ((4 + (b) * 2 + (h)) * HTB)
#define PG8_STAGE(bufoff, gbase, voff) do { _Pragma("unroll") for (int _i = 0; _i < 2; ++_i) \
        __builtin_amdgcn_global_load_lds((const unsigned*)((const char*)(gbase) + (voff)[_i]), (PG8_LAS unsigned*)(lds + (bufoff) + ldsw + _i * 8192), 16, 0, 0); } while (0)
#define PG8_LDA(dst, b, h) do { _Pragma("unroll") for (int m = 0; m < 4; ++m) _Pragma("unroll") for (int k = 0; k < 2; ++k) dst[m][k] = *(const PG8_LAS bf16x8*)(lds + PG8_SA(b, h) + aoff + m * 2048 + k * 1024); } while (0)
#define PG8_LDB(dst, b, h) do { _Pragma("unroll") for (int n = 0; n < 2; ++n) _Pragma("unroll") for (int k = 0; k < 2; ++k) dst[n][k] = *(const PG8_LAS bf16x8*)(lds + PG8_SB(b, h) + boff + n * 2048 + k * 1024); } while (0)
#define PG8_MMA(ai, bj, At, Bt) do { __builtin_amdgcn_s_setprio(1); _Pragma("unroll") for (int m = 0; m < 4; ++m) _Pragma("unroll") for (int n = 0; n < 2; ++n) _Pragma("unroll") for (int k = 0; k < 2; ++k) \
        acc[ai][bj][m][n] = __builtin_amdgcn_mfma_f32_16x16x32_bf16(Bt[n][k], At[m][k], acc[ai][bj][m][n], 0, 0, 0); __builtin_amdgcn_s_setprio(0); } while (0)
#define PG8_WAIT_V(n) asm volatile("s_waitcnt vmcnt(" #n ")" ::: "memory")
#define PG8_WAIT_L(n) asm volatile("s_waitcnt lgkmcnt(" #n ")" ::: "memory")
#define PG8_BAR __builtin_amdgcn_s_barrier()
#define PG8_SCHED __builtin_amdgcn_sched_barrier(0)
    Unit cur, nxt; int ui = 0;
    if (!S.next(0, cur)) return;
    f32x4 acc[2][2][4][2];
#pragma unroll
    for (int a = 0; a < 2; ++a)
#pragma unroll
        for (int b = 0; b < 2; ++b)
#pragma unroll
            for (int m = 0; m < 4; ++m)
#pragma unroll
                for (int n = 0; n < 2; ++n) acc[a][b][m][n] = (f32x4){0.f, 0.f, 0.f, 0.f};
    bf16x8 At[4][2], B0[2][2], B1[2][2];
    const char* cA = (const char*)g.A + (size_t)cur.pm * tstep; const char* cB = (const char*)g.Bt + (size_t)cur.pn * tstep;
    S.a_ready(cur);
    if constexpr (SP2) {
        PG8_STAGE(PG8_SB(0, 0), cB, voffB); PG8_STAGE(PG8_SB(0, 1), cB + hstep, voffB); PG8_STAGE(PG8_SA(0, 0), cA, voffA); PG8_STAGE(PG8_SA(0, 1), cA + hstep, voffA);
        if (wr == 1) PG8_BAR;
        PG8_WAIT_V(2); PG8_BAR;
        PG8_STAGE(PG8_SB(1, 0), cB + kstep, voffB); PG8_STAGE(PG8_SA(1, 0), cA + kstep, voffA); PG8_STAGE(PG8_SB(1, 1), cB + hstep + kstep, voffB);
        PG8_WAIT_V(6); PG8_BAR;
    } else {
        PG8_STAGE(PG8_SB(0, 0), cB, voffB); PG8_STAGE(PG8_SA(0, 0), cA, voffA); PG8_STAGE(PG8_SB(0, 1), cB + hstep, voffB); PG8_STAGE(PG8_SA(0, 1), cA + hstep, voffA);
        if (wr == 1) PG8_BAR;
        PG8_WAIT_V(4); PG8_BAR;
        PG8_STAGE(PG8_SB(1, 0), cB + kstep, voffB); PG8_STAGE(PG8_SA(1, 0), cA + kstep, voffA); PG8_STAGE(PG8_SB(1, 1), cB + hstep + kstep, voffB);
        PG8_WAIT_V(6); PG8_BAR;
    }
    for (;;) {
        const bool has_next = S.next(ui + 1, nxt);
        const char* nA = has_next ? (const char*)g.A + (size_t)nxt.pm * tstep : cA; const char* nB = has_next ? (const char*)g.Bt + (size_t)nxt.pn * tstep : cB;
        for (int t = 0; t < nt; t += 2) {
            const bool last = (t == nt - 2);
            const char* a1 = cA + (size_t)(t + 1) * kstep;
            const char* a2 = last ? nA : cA + (size_t)(t + 2) * kstep; const char* b2 = last ? nB : cB + (size_t)(t + 2) * kstep;
            const char* a3 = a2 + kstep; const char* b3 = b2 + kstep;
            if (last && has_next) S.a_ready(nxt);
            if constexpr (SP2) {
            PG8_LDB(B0, 0, 0); PG8_LDB(B1, 0, 1); PG8_SCHED; PG8_LDA(At, 0, 0); PG8_STAGE(PG8_SA(1, 1), a1 + hstep, voffA);
            PG8_WAIT_V(8); PG8_WAIT_L(0); PG8_BAR; PG8_MMA(0, 0, At, B0); PG8_MMA(0, 1, At, B1); PG8_BAR; PG8_SCHED;
            PG8_LDA(At, 0, 1); PG8_STAGE(PG8_SB(0, 0), b2, voffB); PG8_STAGE(PG8_SB(0, 1), b2 + hstep, voffB); PG8_STAGE(PG8_SA(0, 0), a2, voffA);
            PG8_WAIT_V(8); PG8_WAIT_L(0); PG8_BAR; PG8_MMA(1, 0, At, B0); PG8_MMA(1, 1, At, B1); PG8_BAR; PG8_SCHED;
            PG8_LDB(B0, 1, 0); PG8_LDB(B1, 1, 1); PG8_SCHED; PG8_LDA(At, 1, 0); PG8_STAGE(PG8_SA(0, 1), a2 + hstep, voffA);
            PG8_WAIT_V(8); PG8_WAIT_L(0); PG8_BAR; PG8_MMA(0, 0, At, B0); PG8_MMA(0, 1, At, B1); PG8_BAR; PG8_SCHED;
            PG8_LDA(At, 1, 1); PG8_STAGE(PG8_SB(1, 0), b3, voffB); PG8_STAGE(PG8_SB(1, 1), b3 + hstep, voffB); PG8_STAGE(PG8_SA(1, 0), a3, voffA);
            PG8_WAIT_V(8); PG8_WAIT_L(0); PG8_BAR; PG8_MMA(1, 0, At, B0); PG8_MMA(1, 1, At, B1); PG8_BAR; PG8_SCHED;
            } else {
            PG8_LDB(B0, 0, 0); PG8_SCHED; PG8_LDA(At, 0, 0); PG8_STAGE(PG8_SA(1, 1), a1 + hstep, voffA);
            PG8_WAIT_L(8); PG8_BAR; PG8_WAIT_L(0); PG8_MMA(0, 0, At, B0); PG8_BAR; PG8_SCHED;
            PG8_LDB(B1, 0, 1); PG8_STAGE(PG8_SB(0, 0), b2, voffB);
            PG8_BAR; PG8_WAIT_L(0); PG8_MMA(0, 1, At, B1); PG8_BAR;
            PG8_LDA(At, 0, 1); PG8_STAGE(PG8_SA(0, 0), a2, voffA);
            PG8_BAR; PG8_WAIT_L(0); PG8_MMA(1, 0, At, B0); PG8_BAR; PG8_SCHED;
            PG8_STAGE(PG8_SB(0, 1), b2 + hstep, voffB);
            PG8_WAIT_V(6); PG8_BAR; PG8_MMA(1, 1, At, B1); PG8_BAR;
            PG8_LDB(B0, 1, 0); PG8_SCHED; PG8_LDA(At, 1, 0); PG8_STAGE(PG8_SA(0, 1), a2 + hstep, voffA);
            PG8_WAIT_L(8); PG8_BAR; PG8_WAIT_L(0); PG8_MMA(0, 0, At, B0); PG8_BAR; PG8_SCHED;
            PG8_LDB(B1, 1, 1); PG8_STAGE(PG8_SB(1, 0), b3, voffB);
            PG8_BAR; PG8_WAIT_L(0); PG8_MMA(0, 1, At, B1); PG8_BAR;
            PG8_LDA(At, 1, 1); PG8_STAGE(PG8_SA(1, 0), a3, voffA);
            PG8_BAR; PG8_WAIT_L(0); PG8_MMA(1, 0, At, B0); PG8_BAR; PG8_SCHED;
            PG8_STAGE(PG8_SB(1, 1), b3 + hstep, voffB);
            PG8_WAIT_V(6); PG8_BAR; PG8_MMA(1, 1, At, B1); PG8_BAR;
            }
        }
        if constexpr (ALIGN_EPI) { if (wr == 0) PG8_BAR; }
        if constexpr (!Epi::AFTER_DRAIN) { E(acc, cur, wr, wc, fr, fq); S.done(cur); }
        if (!has_next) break;
#pragma unroll
        for (int a = 0; a < 2; ++a)
#pragma unroll
            for (int b = 0; b < 2; ++b)
#pragma unroll
                for (int m = 0; m < 4; ++m)
#pragma unroll
                    for (int n = 0; n < 2; ++n) acc[a][b][m][n] = (f32x4){0.f, 0.f, 0.f, 0.f};
        cur = nxt; cA = nA; cB = nB; ++ui;
        if constexpr (ALIGN_EPI) { if (wr == 1) PG8_BAR; }
    }
    PG8_WAIT_V(0);
    if constexpr (!ALIGN_EPI) { if (wr == 0) PG8_BAR; }
    PG8_BAR;
    if constexpr (Epi::AFTER_DRAIN) { E.fused(acc, cur, wr, wc, fr, fq, lds, wid, lane); S.done(cur); }
#undef PG8_SA
#undef PG8_SB
#undef PG8_STAGE
#undef PG8_LDA
#undef PG8_LDB
#undef PG8_MMA
#undef PG8_WAIT_V
#undef PG8_WAIT_L
#undef PG8_BAR
#undef PG8_SCHED
}
}
#define GAS __attribute__((address_space(1)))
#define LAS __attribute__((address_space(3)))
typedef unsigned short bf16;
typedef unsigned v4u __attribute__((ext_vector_type(4)));
using pg8::f32x4;
using pg8::bf16x8;
typedef GAS unsigned gu32;
typedef GAS unsigned long long gu64;
#define RLX_AGENT __ATOMIC_RELAXED, __HIP_MEMORY_SCOPE_AGENT
#define LDS_WAIT() asm volatile("s_waitcnt lgkmcnt(0)" ::: "memory")
#define VM_WAIT() asm volatile("s_waitcnt vmcnt(0)" ::: "memory")
__device__ __forceinline__ unsigned long long rt() { return __builtin_amdgcn_s_memrealtime(); }
__device__ __forceinline__ unsigned f2bf(float f) { unsigned u = __builtin_bit_cast(unsigned, f); return (u + 0x7fffu + ((u >> 16) & 1u)) >> 16; }
__device__ __forceinline__ unsigned pk2(float lo, float hi) { return f2bf(lo) | (f2bf(hi) << 16); }

#define XB_TMO      128
#define XB_XCNT(j)  (256  + 64 * (j))
#define XB_XSUB(j)  (1280 + 64 * (j))
#define XB_XGEN(j)  (2304 + 64 * (j))
#define XB_TOP      3328
#define XB_TOPGEN   3392
#define XCD_BAR_WORDS 3456
#define XB_SPIN_CAP (1u << 18)

__device__ __forceinline__ unsigned xb_ld(unsigned* p)              { return __hip_atomic_load(p, __ATOMIC_RELAXED, __HIP_MEMORY_SCOPE_AGENT); }
__device__ __forceinline__ unsigned xb_add(unsigned* p, unsigned v) { return __hip_atomic_fetch_add(p, v, __ATOMIC_RELAXED, __HIP_MEMORY_SCOPE_AGENT); }
__device__ __forceinline__ unsigned xb_xcc_id() { return (unsigned)__builtin_amdgcn_s_getreg((3 << 11) | 20) & 0xFu; }
#define XB_SPIN(cond, bar) do { unsigned _sp = 0; while (cond) { __builtin_amdgcn_s_sleep(1); \
    if ((++_sp & 255u) == 0u) { if (xb_ld(&(bar)[XB_TMO])) break; if (_sp > XB_SPIN_CAP) { atomicAdd(&(bar)[XB_TMO], 1u); break; } } } } while (0)

struct XcdBarrier {
    unsigned* bar; unsigned x;
    volatile LAS unsigned* st;
};

__device__ __forceinline__ XcdBarrier xcd_barrier_post(unsigned* bar, volatile LAS unsigned* st) {
    XcdBarrier b; b.bar = bar; b.x = xb_xcc_id(); b.st = st;
    if (threadIdx.x == 0) (void)xb_add(&bar[XB_XCNT(b.x)], 1u);
    return b;
}
__device__ __forceinline__ void xcd_barrier_complete(unsigned* bar, unsigned x, unsigned& nloc, unsigned& nx) {
    const unsigned G = gridDim.x * gridDim.y * gridDim.z;
    unsigned sum, cnt, mine, sp = 0u;
    for (;;) {
        sum = 0u; cnt = 0u; mine = 0u;
#pragma unroll
        for (unsigned j = 0; j < 16; ++j) { const unsigned c = xb_ld(&bar[XB_XCNT(j)]); sum += c; cnt += (c > 0u) ? 1u : 0u; mine = (j == x) ? c : mine; }
        if (sum == G) break;
        __builtin_amdgcn_s_sleep(1);
        if ((++sp & 255u) == 0u) { if (xb_ld(&bar[XB_TMO])) break; if (sp > XB_SPIN_CAP) { atomicAdd(&bar[XB_TMO], 1u); break; } }
    }
    nloc = mine > 0u ? mine : 1u; nx = cnt > 0u ? cnt : 1u;
}

__device__ __forceinline__ void xcd_barrier(const XcdBarrier& b) {
    asm volatile("s_waitcnt vmcnt(0)" ::: "memory");
    __syncthreads();
    if (threadIdx.x == 0) {
        unsigned* bar = b.bar;
        __builtin_amdgcn_s_waitcnt(0);
        unsigned nloc = b.st[0], nx = b.st[1];
        if (nloc == 0u) { xcd_barrier_complete(bar, b.x, nloc, nx); b.st[0] = nloc; b.st[1] = nx; }
        const unsigned old = xb_add(&bar[XB_XSUB(b.x)], 1u);
        const unsigned gen = old / nloc;
        if (old + 1u == (gen + 1u) * nloc) {
            __builtin_amdgcn_fence(__ATOMIC_RELEASE, "agent");
            asm volatile("s_waitcnt vmcnt(0)" ::: "memory");
            const unsigned og = xb_add(&bar[XB_TOP], 1u);
            const unsigned tg = og / nx;
            if (og + 1u == (tg + 1u) * nx) xb_add(&bar[XB_TOPGEN], 1u);
            else XB_SPIN(xb_ld(&bar[XB_TOPGEN]) == tg, bar);
            __builtin_amdgcn_fence(__ATOMIC_ACQUIRE, "agent");
            xb_add(&bar[XB_XGEN(b.x)], 1u);
            asm volatile("s_waitcnt vmcnt(0)" ::: "memory");
        } else {
            XB_SPIN(xb_ld(&bar[XB_XGEN(b.x)]) == gen, bar);
            __builtin_amdgcn_fence(__ATOMIC_ACQUIRE, "agent");
            asm volatile("s_waitcnt vmcnt(0)" ::: "memory");
        }
    }
    __syncthreads();
}

constexpr int DM = 1024, NB = 8, SEQ = 4096, MP = NB * SEQ, NS = 128;
constexpr int RTOT = 33024;
constexpr int MEMR = 2048;
constexpr int XNR = RTOT + MEMR;
constexpr int NIN = 6160, NMAIN = 6144, NMEMC = 1024, NTOT = NMAIN + NMEMC;
constexpr int TM_MAIN = RTOT / 256, TN_MAIN = NMAIN / 256, TM_MEM = MEMR / 256, TN_MEM = NMEMC / 256;
constexpr int NU_MAIN = TM_MAIN * TN_MAIN, NU_MEM = TM_MEM * TN_MEM;
constexpr int CONVD = 2048, NHS = 16, NGRP = 4, PH = 64, NST = 128, LCH = 128, NCH = SEQ / LCH;
constexpr int AH = 8, AD = 64, AW = 512, CH_ = 4, CD = 128, MEML = 256, WBUF = 2048;
constexpr float EPS = 1e-6f;
constexpr float C2A = 0.125f * 1.4426950408889634f;
constexpr float C2C = 0.08838834764831845f * 1.4426950408889634f;
constexpr int ROPE_ROWS = 4096 + 256;
enum { I_XP = 0, I_XS, I_MEM, I_CWK, I_CWV, I_CMK, I_CMV, I_SCONV, I_SSSM, I_POS, I_LNG, I_WIN, I_CONVW, I_CONVB, I_DTB, I_ALOG, I_DSKIP, I_SSDG, I_MEMG, I_WMEM, I_WOUT, I_FNG, N_INPUTS };
constexpr size_t O_YP = 0, O_YS = O_YP + (size_t)MP * DM, O_WKP = O_YS + (size_t)NS * DM, O_WVP = O_WKP + (size_t)NB * WBUF * AW, O_MKP = O_WVP + (size_t)NB * WBUF * AW,
                 O_MVP = O_MKP + (size_t)MEMR * 512, O_CVP = O_MVP + (size_t)MEMR * 512, O_SSP = O_CVP + (size_t)NB * 3 * CONVD, O_WKS = O_SSP + (size_t)NB * NHS * PH * NST,
                 O_WVS = O_WKS + (size_t)NS * AW, O_CVS = O_WVS + (size_t)NS * AW, O_SSS = O_CVS + (size_t)NS * 3 * CONVD, O_END = O_SSS + (size_t)NS * NHS * PH * NST;
static_assert(O_END == 71352320, "output size");

constexpr size_t MiB = 1u << 20;
constexpr size_t WS_CTL = 0, CTL_ZERO_BYTES = 1 * MiB;
constexpr size_t WS_WT = 2 * MiB;
constexpr size_t WS_WOT = 16 * MiB;
constexpr size_t WS_ROPE = 21 * MiB;
constexpr size_t WS_RSTD = 22 * MiB;
constexpr size_t WS_DT = 23 * MiB;
constexpr size_t WS_CSUM = 26 * MiB;
constexpr size_t WS_CDEC = 28 * MiB;
constexpr size_t WS_XN = 32 * MiB;
constexpr size_t WS_SZ = 104 * MiB;
constexpr size_t WS_XBC = 172 * MiB;
constexpr size_t WS_Q = 304 * MiB, WS_K = 338 * MiB, WS_V = 372 * MiB, WS_GA = 406 * MiB, WS_QC = 440 * MiB, WS_GC = 474 * MiB;
constexpr size_t WS_MK = 508 * MiB, WS_MV = 510 * MiB;
constexpr size_t WS_OPART = 512 * MiB;
constexpr size_t WS_ML = 608 * MiB;
constexpr size_t WS_STL = 616 * MiB;
constexpr size_t WS_SPREV = 744 * MiB;
constexpr size_t WS_CAT = 808 * MiB;
constexpr size_t WS_SMP = 940 * MiB;
constexpr size_t WS_END = 944 * MiB;
static_assert(WS_XN + (size_t)XNR * DM * 2 <= WS_SZ && WS_SZ + (size_t)RTOT * DM * 2 <= WS_XBC && WS_XBC + (size_t)RTOT * CONVD * 2 <= WS_Q && WS_GC + (size_t)RTOT * 512 * 2 <= WS_MK, "ws map");
static_assert(WS_CAT + (size_t)RTOT * 2048 * 2 <= WS_SMP && WS_WT + (size_t)NTOT * DM * 2 <= WS_WOT, "ws map 2");
constexpr int CW_TMO = 0, CW_CODE = 1, CW_BAR = 4096;

constexpr int LDS_BYTES = 147456;
constexpr int MISC_OFF = LDS_BYTES - 128;
constexpr int SCR_BYTES = MISC_OFF;
constexpr int NWAVES = 8;

struct Frame {
    LAS unsigned char* lds;
    volatile LAS unsigned* MISC;
    gu32* ctl;
    int tid, lane, wave, vcu, G;
    const float *xp, *xs, *mem, *cwk, *cwv, *cmk, *cmv, *sconv, *sssm, *pos, *lng, *win, *convw, *convb, *dtb, *alog, *dskip, *ssdg, *memg, *wmem, *wout, *fng;
    float* out; unsigned char* ws;
};
__device__ __forceinline__ float wave_sum(float v) {
#pragma unroll
    for (int o = 1; o < 64; o <<= 1) v += __shfl_xor(v, o);
    return v;
}
__device__ __forceinline__ float fast_exp2(float x) { return __builtin_amdgcn_exp2f(x); }
__device__ __forceinline__ float fast_rcp(float x) { return __builtin_amdgcn_rcpf(x); }
__device__ __forceinline__ float silu_f(float x) { return x * fast_rcp(1.0f + fast_exp2(-1.4426950408889634f * x)); }

__device__ __forceinline__ void p0_transpose_item(const float* W, int ldw, int col0, const float* gain, bf16* WT, int K, int nrow0, int k0, LAS float* scr, int lane) {
#pragma unroll
    for (int i = 0; i < 32; ++i) { const int kk = 2 * i + (lane >> 5); float v = W[(size_t)(k0 + kk) * ldw + col0 + (lane & 31)]; if (gain) v *= gain[k0 + kk]; scr[kk * 33 + (lane & 31)] = v; }
    LDS_WAIT(); asm volatile("" ::: "memory");
    const int c = lane & 7;
#pragma unroll
    for (int j = 0; j < 4; ++j) { const int n = (lane >> 3) + 8 * j; const LAS float* s = scr + (8 * c) * 33 + n;
        v4u o; o.x = pk2(s[0 * 33], s[1 * 33]); o.y = pk2(s[2 * 33], s[3 * 33]); o.z = pk2(s[4 * 33], s[5 * 33]); o.w = pk2(s[6 * 33], s[7 * 33]);
        *(GAS v4u*)(WT + (size_t)(nrow0 + n) * K + k0 + 8 * c) = o; }
    LDS_WAIT(); asm volatile("" ::: "memory");
}
template <int KIND> __device__ __forceinline__ void p0_row_item(Frame& F, int row0, const float* src0, const LAS float* gw4) {
    const int lane = F.lane, r = lane & 15, q = lane >> 4, row = row0 + r;
    constexpr bool with_dt = KIND == 0, zero = KIND == 1;
    const float* src = src0 + (size_t)r * DM;
    bf16* dst = (bf16*)(F.ws + WS_XN) + (size_t)row * DM;
    f32x4 acc = {0.f, 0.f, 0.f, 0.f}; float ss = 0.f;
    if (zero) {
#pragma unroll 4
        for (int kb = 0; kb < 16; ++kb) { v4u z = {0u, 0u, 0u, 0u}; *(GAS v4u*)(dst + 64 * kb + 16 * q) = z; *(GAS v4u*)(dst + 64 * kb + 16 * q + 8) = z; }
        if (q == 0) ((float*)(F.ws + WS_RSTD))[row] = 0.f;
        return;
    }
#pragma unroll 2
    for (int kb = 0; kb < 16; ++kb) {
        f32x4 v[4];
#pragma unroll
        for (int e = 0; e < 4; ++e) v[e] = *(const GAS f32x4*)(src + 64 * kb + 16 * q + 4 * e);
#pragma unroll
        for (int e = 0; e < 4; ++e) ss += (v[e].x * v[e].x + v[e].y * v[e].y) + (v[e].z * v[e].z + v[e].w * v[e].w);
        v4u o0, o1;
        o0.x = pk2(v[0].x, v[0].y); o0.y = pk2(v[0].z, v[0].w); o0.z = pk2(v[1].x, v[1].y); o0.w = pk2(v[1].z, v[1].w);
        o1.x = pk2(v[2].x, v[2].y); o1.y = pk2(v[2].z, v[2].w); o1.z = pk2(v[3].x, v[3].y); o1.w = pk2(v[3].z, v[3].w);
        *(GAS v4u*)(dst + 64 * kb + 16 * q) = o0; *(GAS v4u*)(dst + 64 * kb + 16 * q + 8) = o1;
        if (with_dt) {
#pragma unroll
            for (int e4 = 0; e4 < 4; ++e4) { const f32x4 w = *(const LAS f32x4*)(gw4 + ((16 * kb + 4 * q + e4) * 16 + r) * 4);
                acc = __builtin_amdgcn_mfma_f32_16x16x4f32(v[e4].x, w.x, acc, 0, 0, 0); acc = __builtin_amdgcn_mfma_f32_16x16x4f32(v[e4].y, w.y, acc, 0, 0, 0);
                acc = __builtin_amdgcn_mfma_f32_16x16x4f32(v[e4].z, w.z, acc, 0, 0, 0); acc = __builtin_amdgcn_mfma_f32_16x16x4f32(v[e4].w, w.w, acc, 0, 0, 0); }
        }
    }
    ss += __shfl_xor(ss, 16); ss += __shfl_xor(ss, 32);
    const float rstd = 1.0f / sqrtf(ss * (1.0f / DM) + EPS);
    if (q == 0) ((float*)(F.ws + WS_RSTD))[row] = rstd;
    if (with_dt) {
        const float bias = F.dtb[r]; float* DT = (float*)(F.ws + WS_DT);
#pragma unroll
        for (int g = 0; g < 4; ++g) { const float rs = __shfl(rstd, 4 * q + g); const float v = acc[g] * rs + bias;
            const float sp = fmaxf(v, 0.f) + log1pf(expf(-fabsf(v))); DT[(size_t)(row0 + 4 * q + g) * 16 + r] = sp; }
    }
}
__device__ __forceinline__ void p0_prologue(Frame& F) {
    LAS float* gw4 = (LAS float*)F.lds;
    LAS float* scr = (LAS float*)(F.lds + 65536 + F.wave * 8448);
    { const float* W = F.win; const float* g = F.lng;
      f32x4 wv[8]; float gv[8];
#pragma unroll
      for (int k = 0; k < 8; ++k) { const int idx4 = F.tid + 512 * k, kr = idx4 >> 2, j4 = idx4 & 3; wv[k] = *(const GAS f32x4*)(W + (size_t)kr * NIN + 3072 + 4 * j4); gv[k] = g[kr]; }
#pragma unroll
      for (int k = 0; k < 8; ++k) { const int idx4 = F.tid + 512 * k, kr = idx4 >> 2, j4 = idx4 & 3; LAS float* d = gw4 + ((kr >> 2) * 16 + 4 * j4) * 4 + (kr & 3);
          d[0] = wv[k].x * gv[k]; d[4] = wv[k].y * gv[k]; d[8] = wv[k].z * gv[k]; d[12] = wv[k].w * gv[k]; } }
    __syncthreads();
    const int gw = F.vcu * NWAVES + F.wave, NGW = F.G * NWAVES;
    for (int it = gw; it < MP / 16; it += NGW) p0_row_item<0>(F, it * 16, F.xp + (size_t)it * 16 * DM, gw4);
    for (int it = gw; it < NS / 16; it += NGW) p0_row_item<0>(F, MP + it * 16, F.xs + (size_t)it * 16 * DM, gw4);
    for (int it = gw; it < (RTOT - MP - NS) / 16; it += NGW) p0_row_item<1>(F, MP + NS + it * 16, nullptr, gw4);
    for (int it = gw; it < MEMR / 16; it += NGW) p0_row_item<2>(F, RTOT + it * 16, F.mem + (size_t)it * 16 * DM, gw4);
    constexpr int I_A = 16 * 192, I_B = 16 * 32, I_C = 32 * 32;
    bf16* WT = (bf16*)(F.ws + WS_WT); bf16* WOT = (bf16*)(F.ws + WS_WOT);
    for (int it = gw; it < I_A + I_B + I_C; it += NGW) {
        int r = it;
        if (r < I_A) { const int kb = r / 192, nb = r % 192, n0 = nb * 32; p0_transpose_item(F.win, NIN, n0 < 3072 ? n0 : n0 + 16, F.lng, WT, DM, n0, kb * 64, scr, F.lane); continue; } r -= I_A;
        if (r < I_B) { const int kb = r / 32, nb = r % 32; p0_transpose_item(F.wmem, 1024, nb * 32, F.memg, WT, DM, NMAIN + nb * 32, kb * 64, scr, F.lane); continue; } r -= I_B;
        { const int kb = r / 32, nb = r % 32; p0_transpose_item(F.wout, 1024, nb * 32, nullptr, WOT, 2048, nb * 32, kb * 64, scr, F.lane); }
    }
    { float* rope = (float*)(F.ws + WS_ROPE); const int* pos = (const int*)F.pos;
      const int gt = F.vcu * (NWAVES * 64) + F.tid, NGT = F.G * NWAVES * 64;
      for (int idx = gt; idx < ROPE_ROWS * 8; idx += NGT) { const int pi = idx >> 3, i = idx & 7; const int p = pi < 4096 ? pi : (pi < 4096 + NS ? pos[pi - 4096] : 0);
          const float inv = (float)exp2(-(double)i * 2.3664460711655217); const float ang = (float)p * inv; rope[pi * 16 + i] = cosf(ang); rope[pi * 16 + 8 + i] = sinf(ang); } }
}

__device__ __forceinline__ void st8_bf16(bf16* p, const f32x4 a, const f32x4 b) { v4u w; w.x = pg8::cvt_pk_bf16(a.x, a.y); w.y = pg8::cvt_pk_bf16(a.z, a.w); w.z = pg8::cvt_pk_bf16(b.x, b.y); w.w = pg8::cvt_pk_bf16(b.z, b.w); *(GAS v4u*)p = w; }
__device__ __forceinline__ void st8_f32(float* p, const f32x4 a, const f32x4 b) { *(GAS f32x4*)p = a; *(GAS f32x4*)(p + 4) = b; }
__device__ __forceinline__ f32x4 silu4(const f32x4 v) { f32x4 o; o.x = silu_f(v.x); o.y = silu_f(v.y); o.z = silu_f(v.z); o.w = silu_f(v.w); return o; }
__device__ __forceinline__ f32x4 shx16(const f32x4 v) { f32x4 o; o.x = __shfl_xor(v.x, 16); o.y = __shfl_xor(v.y, 16); o.z = __shfl_xor(v.z, 16); o.w = __shfl_xor(v.w, 16); return o; }
enum { TK_Z = 0, TK_XBC, TK_Q, TK_K, TK_V, TK_GA, TK_QC, TK_GC, TK_MEM };
struct Epi1 {
    static constexpr bool PERM = true, AFTER_DRAIN = false;
    const float* rstd; const float* rope; float* out; unsigned char* ws;
    template <int T> __device__ __forceinline__ void tile(const pg8::f32x4 (&acc)[2][2][4][2], const pg8::Unit& u, int wr, int wc, int fr, int fq) const {
        const int pm = u.pm, pn = u.pn, lc = wc * 32 + 8 * fq, rbase = pm * 256 + wr * 64 + fr;
        bf16* O; int ld, col0;
        if (T == TK_Z) { O = (bf16*)(ws + WS_SZ); ld = 1024; col0 = pn * 256; }
        else if (T == TK_XBC) { O = (bf16*)(ws + WS_XBC); ld = 2048; col0 = (pn - 4) * 256; }
        else if (T == TK_MEM) { O = (bf16*)(ws + (pn < 26 ? WS_MK : WS_MV)); ld = 512; col0 = (pn & 1) * 256; }
        else { O = (bf16*)(ws + WS_Q + (size_t)((pn - 12) >> 1) * (34 * MiB)); ld = 512; col0 = (pn & 1) * 256; }
        const bool rotw = (T == TK_Q || T == TK_K) && ((wc & 1) == 0);
        const float sgn = fq == 0 ? -1.f : 1.f;
        float rsv[2][4];
#pragma unroll
        for (int ai = 0; ai < 2; ++ai)
#pragma unroll
            for (int m = 0; m < 4; ++m) rsv[ai][m] = rstd[rbase + ai * 128 + m * 16];
#pragma unroll
        for (int ai = 0; ai < 2; ++ai)
#pragma unroll
            for (int m = 0; m < 4; ++m) {
                const int row = rbase + ai * 128 + m * 16; const float rs = rsv[ai][m];
                f32x4 c0, c1, s0, s1;
                if (T == TK_Q || T == TK_K) { if (rotw && fq < 2) { const int prow = row < MP ? (row & 4095) : 4096 + (row - MP); const float* rp = rope + (size_t)prow * 16;
                    c0 = *(const GAS f32x4*)rp; c1 = *(const GAS f32x4*)(rp + 4); s0 = *(const GAS f32x4*)(rp + 8) * sgn; s1 = *(const GAS f32x4*)(rp + 12) * sgn; } }
#pragma unroll
                for (int bj = 0; bj < 2; ++bj) {
                    f32x4 a = acc[ai][bj][m][0] * rs, b = acc[ai][bj][m][1] * rs; const int col = col0 + bj * 128 + lc;
                    if (T == TK_Q || T == TK_K) { if (rotw) { const f32x4 pa = shx16(a), pb = shx16(b); if (fq < 2) { a = a * c0 + pa * s0; b = b * c1 + pb * s1; } } }
                    if (T == TK_Z || T == TK_GA || T == TK_GC) { a = silu4(a); b = silu4(b); }
                    if (T == TK_Q) { a = a * C2A; b = b * C2A; }
                    if (T == TK_QC) { a = a * C2C; b = b * C2C; }
                    if (T == TK_MEM) { const int mrow = row - RTOT; st8_bf16(O + (size_t)mrow * ld + col, a, b); st8_f32(out + (pn < 26 ? O_MKP : O_MVP) + (size_t)mrow * 512 + col, a, b); }
                    else {
                        st8_bf16(O + (size_t)row * ld + col, a, b);
                        if (T == TK_K || T == TK_V) {
                            if (pm < 128) { if ((pm & 15) >= 8) { const int bb = row >> 12, s = row & 4095; st8_f32(out + (T == TK_K ? O_WKP : O_WVP) + ((size_t)bb * WBUF + (s - 2048)) * AW + col, a, b); } }
                            else if (row < MP + NS) st8_f32(out + (T == TK_K ? O_WKS : O_WVS) + (size_t)(row - MP) * AW + col, a, b);
                        }
                        if (T == TK_XBC) {
                            if (pm < 128) { if ((pm & 15) == 15) { const int bb = row >> 12, s = row & 4095; if (s >= 4093) st8_f32(out + O_CVP + ((size_t)bb * 3 + (s - 4093)) * CONVD + col, a, b); } }
                            else if (row < MP + NS) st8_f32(out + O_CVS + ((size_t)(row - MP) * 3 + 2) * CONVD + col, a, b);
                        }
                    }
                }
            }
    }
    __device__ __forceinline__ void operator()(const pg8::f32x4 (&acc)[2][2][4][2], const pg8::Unit& u, int wr, int wc, int fr, int fq) const {
        const int pn = u.pn;
        if (pn < 4) tile<TK_Z>(acc, u, wr, wc, fr, fq);
        else if (pn < 12) tile<TK_XBC>(acc, u, wr, wc, fr, fq);
        else if (pn < 14) tile<TK_Q>(acc, u, wr, wc, fr, fq);
        else if (pn < 16) tile<TK_K>(acc, u, wr, wc, fr, fq);
        else if (pn < 18) tile<TK_V>(acc, u, wr, wc, fr, fq);
        else if (pn < 20) tile<TK_GA>(acc, u, wr, wc, fr, fq);
        else if (pn < 22) tile<TK_QC>(acc, u, wr, wc, fr, fq);
        else if (pn < 24) tile<TK_GC>(acc, u, wr, wc, fr, fq);
        else tile<TK_MEM>(acc, u, wr, wc, fr, fq);
    }
};
struct Sched1 {
    int G, c;
    __device__ __forceinline__ bool next(int i, pg8::Unit& u) const {
        const int L = i * G + c; if (L >= NU_MAIN + NU_MEM) return false;
        if (L < NU_MAIN) {
            constexpr int nM = TM_MAIN, nN = TN_MAIN, nwg = NU_MAIN, q = nwg / 8, r = nwg % 8;
            const int xcd = L % 8, off = L / 8; const int wgid = (xcd < r ? xcd * (q + 1) : r * (q + 1) + (xcd - r) * q) + off;
            constexpr int nig = pg8::WGM * nN; const int gid = wgid / nig, fm = gid * pg8::WGM, gsz = (nM - fm) < pg8::WGM ? (nM - fm) : pg8::WGM;
            u.pm = fm + ((wgid % nig) % gsz); u.pn = (wgid % nig) / gsz;
        } else { const int t = L - NU_MAIN; u.pm = TM_MAIN + (t >> 2); u.pn = TN_MAIN + (t & 3); }
        return true;
    }
    __device__ __forceinline__ void a_ready(const pg8::Unit&) const {}
    __device__ __forceinline__ void done(const pg8::Unit&) const {}
};

typedef short s16x4 __attribute__((ext_vector_type(4)));
typedef short v4i16_t __attribute__((ext_vector_type(4)));
typedef const LAS unsigned char* lcp;
#define MFMA16(a, b, c) __builtin_amdgcn_mfma_f32_16x16x32_bf16((a), (b), (c), 0, 0, 0)
__device__ __forceinline__ s16x4 tr64(lcp p) { return __builtin_bit_cast(s16x4, __builtin_amdgcn_ds_read_tr16_b64_v4i16((LAS v4i16_t*)p)); }
__device__ __forceinline__ bf16x8 frag_row(lcp base, int ldb, int r0, int k0, int lane) { return *(const LAS bf16x8*)(base + (r0 + (lane & 15)) * ldb + (k0 + 8 * (lane >> 4)) * 2); }
__device__ __forceinline__ bf16x8 frag_tr2(lcp base, int ldb, int kA, int kB, int c0, int lane) {
    const int g = lane >> 4, i = lane & 15, q = i >> 2, p = i & 3;
    const s16x4 lo = tr64(base + (kA + 4 * g + q) * ldb + (c0 + 4 * p) * 2), hi = tr64(base + (kB + 4 * g + q) * ldb + (c0 + 4 * p) * 2);
    bf16x8 r; r[0] = lo[0]; r[1] = lo[1]; r[2] = lo[2]; r[3] = lo[3]; r[4] = hi[0]; r[5] = hi[1]; r[6] = hi[2]; r[7] = hi[3]; return r;
}
__device__ __forceinline__ bf16x8 frag_tr(lcp base, int ldb, int k0, int c0, int lane) { const int g = lane >> 4; return frag_tr2(base, ldb, k0 + 4 * g, k0 + 4 * g + 4, c0, lane); }
__device__ __forceinline__ bf16x8 pack8(const f32x4 a, const f32x4 b) {
    v4u w; w.x = pg8::cvt_pk_bf16(a.x, a.y); w.y = pg8::cvt_pk_bf16(a.z, a.w); w.z = pg8::cvt_pk_bf16(b.x, b.y); w.w = pg8::cvt_pk_bf16(b.z, b.w); return __builtin_bit_cast(bf16x8, w); }
__device__ __forceinline__ float bf2f(unsigned short h) { return __uint_as_float((unsigned)h << 16); }
typedef unsigned v2u __attribute__((ext_vector_type(2)));
typedef float f32x2 __attribute__((ext_vector_type(2)));

constexpr int AT_LD = 144, AT_ROWS = 400, AT_VOFF = AT_ROWS * AT_LD;
__device__ __forceinline__ void attn_unit(Frame& F, int u) {
    const int bh = u / 48, v = u % 48, di = v >> 4, w16 = v & 15;
    const int b = bh >> 3, h = bh & 7;
    const int dil = di == 0 ? 1 : (di == 1 ? 4 : 16);
    const int r = di == 0 ? 0 : (di == 1 ? (w16 >> 2) : w16), qblk = di == 0 ? w16 : (di == 1 ? (w16 & 3) : 0);
    const bf16* Qg = (const bf16*)(F.ws + WS_Q); const bf16* Kg = (const bf16*)(F.ws + WS_K); const bf16* Vg = (const bf16*)(F.ws + WS_V);
    LAS unsigned char* lds = F.lds;
    __syncthreads();
    for (int idx = F.tid; idx < AT_ROWS * 8; idx += NWAVES * 64) {
        const int row = idx >> 3, ch = idx & 7; const int sidx = 256 * qblk - 128 + row;
        v4u kv = {0u, 0u, 0u, 0u}, vv = {0u, 0u, 0u, 0u};
        if (row < 384 && sidx >= 0) { const size_t g = ((size_t)b * SEQ + r + (size_t)dil * sidx) * AW + h * AD + ch * 8; kv = *(const GAS v4u*)(Kg + g); vv = *(const GAS v4u*)(Vg + g); }
        *(LAS v4u*)(lds + row * AT_LD + ch * 16) = kv; *(LAS v4u*)(lds + AT_VOFF + row * AT_LD + ch * 16) = vv;
    }
    __syncthreads();
    const int lane = F.lane, g4 = lane >> 4, ql = lane & 15;
#pragma unroll 1
    for (int it = 0; it < 2; ++it) {
        const int qi0 = 32 * F.wave + 16 * it;
        const size_t qrow = (size_t)b * SEQ + r + (size_t)dil * (256 * qblk + qi0 + ql);
        bf16x8 qf[2];
#pragma unroll
        for (int ks = 0; ks < 2; ++ks) qf[ks] = *(const GAS bf16x8*)(Qg + qrow * AW + h * AD + 32 * ks + 8 * g4);
        f32x4 sc[9];
#pragma unroll
        for (int t = 0; t < 9; ++t) { sc[t] = (f32x4){0.f, 0.f, 0.f, 0.f};
#pragma unroll
            for (int ks = 0; ks < 2; ++ks) sc[t] = MFMA16(frag_row(lds, AT_LD, qi0 + 16 * t, 32 * ks, lane), qf[ks], sc[t]); }
        const float ninf = -__builtin_inff();
#pragma unroll
        for (int e = 0; e < 4; ++e) { if (4 * g4 + e < ql) sc[0][e] = ninf; if (4 * g4 + e > ql) sc[8][e] = ninf; }
        if (qblk == 0) {
#pragma unroll
            for (int t = 0; t < 9; ++t)
#pragma unroll
                for (int e = 0; e < 4; ++e) if (qi0 + 16 * t + 4 * g4 + e < 128) sc[t][e] = ninf;
        }
        float m = ninf;
#pragma unroll
        for (int t = 0; t < 9; ++t) m = fmaxf(m, fmaxf(fmaxf(sc[t][0], sc[t][1]), fmaxf(sc[t][2], sc[t][3])));
        m = fmaxf(m, __shfl_xor(m, 16)); m = fmaxf(m, __shfl_xor(m, 32));
        float l = 0.f;
#pragma unroll
        for (int t = 0; t < 9; ++t)
#pragma unroll
            for (int e = 0; e < 4; ++e) { const float p = fast_exp2(sc[t][e] - m); sc[t][e] = p; l += p; }
        l += __shfl_xor(l, 16); l += __shfl_xor(l, 32);
        f32x4 o[4];
#pragma unroll
        for (int dt = 0; dt < 4; ++dt) o[dt] = (f32x4){0.f, 0.f, 0.f, 0.f};
        const f32x4 zero4 = {0.f, 0.f, 0.f, 0.f};
#pragma unroll
        for (int pr = 0; pr < 5; ++pr) { const bf16x8 pf = pack8(sc[2 * pr], pr < 4 ? sc[2 * pr + 1] : zero4);
#pragma unroll
            for (int dt = 0; dt < 4; ++dt) o[dt] = MFMA16(frag_tr2(lds + AT_VOFF, AT_LD, qi0 + 32 * pr, qi0 + 32 * pr + 16, 16 * dt, lane), pf, o[dt]); }
        const float il = 1.0f / l;
        bf16* OP = (bf16*)(F.ws + WS_OPART) + ((size_t)di * MP + qrow) * AW + h * AD; float* ML = (float*)(F.ws + WS_ML) + (((size_t)di * MP + qrow) * AH + h) * 2;
#pragma unroll
        for (int dt = 0; dt < 4; ++dt) { v2u w; w.x = pg8::cvt_pk_bf16(o[dt][0] * il, o[dt][1] * il); w.y = pg8::cvt_pk_bf16(o[dt][2] * il, o[dt][3] * il); *(GAS v2u*)(OP + 16 * dt + 4 * g4) = w; }
        if (g4 == 0) { ML[0] = m; ML[1] = l; }
    }
}

constexpr int SX_LD = 528, SB_LD = 272;
struct ConvW { f32x4 w[4][2], b[2]; };
__device__ __forceinline__ void conv_load(const Frame& F, int b, int c, int l0, int xch, v4u (&raw)[19], ConvW& cw) {
    const bf16* XBC = (const bf16*)(F.ws + WS_XBC);
    const int s0 = c * LCH + l0;
    const bf16* base = XBC + ((size_t)b * SEQ + s0) * CONVD + xch;
#pragma unroll
    for (int t = 0; t < 19; ++t) { raw[t] = (v4u){0u, 0u, 0u, 0u}; if (s0 - 3 + t >= 0) raw[t] = *(const GAS v4u*)(base + (ptrdiff_t)(t - 3) * CONVD); }
#pragma unroll
    for (int t = 0; t < 4; ++t) { cw.w[t][0] = *(const GAS f32x4*)(F.convw + t * CONVD + xch); cw.w[t][1] = *(const GAS f32x4*)(F.convw + t * CONVD + xch + 4); }
    cw.b[0] = *(const GAS f32x4*)(F.convb + xch); cw.b[1] = *(const GAS f32x4*)(F.convb + xch + 4);
}
template <class Emit> __device__ __forceinline__ void conv_compute(int l0, const v4u (&raw)[19], const ConvW& cw, const Emit& emit) {
#pragma unroll
    for (int i = 0; i < 16; ++i) {
        float y[8];
#pragma unroll
        for (int e = 0; e < 8; ++e) {
            const unsigned x0 = raw[i][e >> 1], x1 = raw[i + 1][e >> 1], x2 = raw[i + 2][e >> 1], x3 = raw[i + 3][e >> 1];
            const float f0 = (e & 1) ? __uint_as_float(x0 & 0xffff0000u) : __uint_as_float(x0 << 16), f1 = (e & 1) ? __uint_as_float(x1 & 0xffff0000u) : __uint_as_float(x1 << 16);
            const float f2 = (e & 1) ? __uint_as_float(x2 & 0xffff0000u) : __uint_as_float(x2 << 16), f3 = (e & 1) ? __uint_as_float(x3 & 0xffff0000u) : __uint_as_float(x3 << 16);
            y[e] = silu_f(cw.b[e >> 2][e & 3] + f0 * cw.w[0][e >> 2][e & 3] + f1 * cw.w[1][e >> 2][e & 3] + f2 * cw.w[2][e >> 2][e & 3] + f3 * cw.w[3][e >> 2][e & 3]);
        }
        emit(l0 + i, y);
        __builtin_amdgcn_sched_barrier(0);
    }
}
__device__ __forceinline__ void st8_lds(LAS unsigned char* p, const float (&y)[8]) { v4u w; w.x = pg8::cvt_pk_bf16(y[0], y[1]); w.y = pg8::cvt_pk_bf16(y[2], y[3]); w.z = pg8::cvt_pk_bf16(y[4], y[5]); w.w = pg8::cvt_pk_bf16(y[6], y[7]); *(LAS v4u*)p = w; }

constexpr int P2S_X = 0, P2S_B = 128 * SX_LD, P2S_CS = P2S_B + 128 * SB_LD, P2S_F = P2S_CS + 2048;
__device__ __forceinline__ void ssd_state_unit(Frame& F, int u) {
    const int b = u >> 7, c = (u >> 2) & 31, g = u & 3;
    LAS unsigned char* lds = F.lds; const int lane = F.lane, wave = F.wave;
    LAS float* csT = (LAS float*)(lds + P2S_CS); LAS float* fT = (LAS float*)(lds + P2S_F);
    __syncthreads();
    if (wave < 4) {
        const int h = 4 * g + wave; const float a = -__expf(F.alog[h]);
        const float* dtp = (const float*)(F.ws + WS_DT) + ((size_t)b * SEQ + c * LCH + 2 * lane) * 16 + h;
        const float d0 = dtp[0], d1 = dtp[16]; const float a0 = d0 * a, a1 = d1 * a;
        float s = a0 + a1;
#pragma unroll
        for (int o = 1; o < 64; o <<= 1) { const float t = __shfl_up(s, o); if (lane >= o) s += t; }
        const float tot = __shfl(s, 63); const float c1 = s, c0 = s - a1;
        csT[wave * 128 + 2 * lane] = c0; csT[wave * 128 + 2 * lane + 1] = c1;
        fT[(2 * lane) * 4 + wave] = d0 * __expf(tot - c0); fT[(2 * lane + 1) * 4 + wave] = d1 * __expf(tot - c1);
        float* CS = (float*)(F.ws + WS_CSUM) + (((size_t)b * NCH + c) * NHS + h) * LCH;
        *(GAS f32x2*)(CS + 2 * lane) = (f32x2){c0, c1};
        if (lane == 0) ((float*)(F.ws + WS_CDEC))[((size_t)b * NCH + c) * NHS + h] = __expf(tot);
    }
    __syncthreads();
    if (F.tid < 384) {
        const int cg = F.tid % 48, seg = F.tid / 48;
        const int xch = cg < 32 ? 256 * g + 8 * cg : 1024 + 128 * g + 8 * (cg - 32);
        v4u raw[19]; ConvW cw; conv_load(F, b, c, 16 * seg, xch, raw, cw);
        conv_compute(16 * seg, raw, cw, [&](int l, float (&y)[8]) {
            if (cg < 32) { const float f = fT[l * 4 + (cg >> 3)];
#pragma unroll
                for (int e = 0; e < 8; ++e) y[e] *= f;
                st8_lds(lds + P2S_X + l * SX_LD + cg * 16, y); }
            else st8_lds(lds + P2S_B + l * SB_LD + (cg - 32) * 16, y);
        });
    }
    __syncthreads();
    f32x4 acc[2][8];
#pragma unroll
    for (int mt = 0; mt < 2; ++mt)
#pragma unroll
        for (int nt = 0; nt < 8; ++nt) acc[mt][nt] = (f32x4){0.f, 0.f, 0.f, 0.f};
#pragma unroll
    for (int ks = 0; ks < 4; ++ks) {
        bf16x8 af[2];
#pragma unroll
        for (int mt = 0; mt < 2; ++mt) af[mt] = frag_tr(lds + P2S_X, SX_LD, 32 * ks, 32 * wave + 16 * mt, lane);
#pragma unroll
        for (int nt = 0; nt < 8; ++nt) { const bf16x8 bfr = frag_tr(lds + P2S_B, SB_LD, 32 * ks, 16 * nt, lane);
#pragma unroll
            for (int mt = 0; mt < 2; ++mt) acc[mt][nt] = MFMA16(af[mt], bfr, acc[mt][nt]); }
    }
    float* STL = (float*)(F.ws + WS_STL) + (((size_t)b * NCH + c) * NHS + 4 * g) * (PH * NST);
#pragma unroll
    for (int mt = 0; mt < 2; ++mt)
#pragma unroll
        for (int e = 0; e < 4; ++e) { const int ch = 32 * wave + 16 * mt + 4 * (lane >> 4) + e;
#pragma unroll
            for (int nt = 0; nt < 8; ++nt) STL[(size_t)ch * NST + 16 * nt + (lane & 15)] = acc[mt][nt][e]; }
}

__device__ __forceinline__ void p3_recurrence(Frame& F) {
    const int gt = F.vcu * (NWAVES * 64) + F.tid, NGT = F.G * NWAVES * 64;
    for (int it = gt; it < NB * NHS * PH * NST / 8; it += NGT) {
        const int n8 = it & 15, p = (it >> 4) & 63, h = (it >> 10) & 15, b = it >> 14;
        float st[8];
#pragma unroll
        for (int e = 0; e < 8; ++e) st[e] = 0.f;
        const size_t eoff = (size_t)p * NST + 8 * n8;
#pragma unroll 4
        for (int c = 0; c < NCH; ++c) {
            const size_t base = (((size_t)b * NCH + c) * NHS + h) * (PH * NST) + eoff;
            const f32x4 l0 = *(const GAS f32x4*)((const float*)(F.ws + WS_STL) + base), l1 = *(const GAS f32x4*)((const float*)(F.ws + WS_STL) + base + 4);
            const float dec = ((const float*)(F.ws + WS_CDEC))[((size_t)b * NCH + c) * NHS + h];
            v4u w; w.x = pg8::cvt_pk_bf16(st[0], st[1]); w.y = pg8::cvt_pk_bf16(st[2], st[3]); w.z = pg8::cvt_pk_bf16(st[4], st[5]); w.w = pg8::cvt_pk_bf16(st[6], st[7]);
            *(GAS v4u*)((bf16*)(F.ws + WS_SPREV) + base) = w;
            st[0] = st[0] * dec + l0.x; st[1] = st[1] * dec + l0.y; st[2] = st[2] * dec + l0.z; st[3] = st[3] * dec + l0.w;
            st[4] = st[4] * dec + l1.x; st[5] = st[5] * dec + l1.y; st[6] = st[6] * dec + l1.z; st[7] = st[7] * dec + l1.w;
        }
        float* o = F.out + O_SSP + (((size_t)b * NHS + h) * PH + p) * NST + 8 * n8;
        *(GAS f32x4*)o = (f32x4){st[0], st[1], st[2], st[3]}; *(GAS f32x4*)(o + 4) = (f32x4){st[4], st[5], st[6], st[7]};
    }
}

constexpr int CR_LD = 272, CR_VOFF = 256 * CR_LD;
__device__ __forceinline__ void cross_group(Frame& F, int gidx) {
    const int bhc = gidx >> 3, b = bhc >> 2, hc = bhc & 3, qb0 = (gidx & 7) * 4;
    LAS unsigned char* lds = F.lds; const int lane = F.lane, g4 = lane >> 4, ql = lane & 15;
    const bf16* MK = (const bf16*)(F.ws + WS_MK); const bf16* MV = (const bf16*)(F.ws + WS_MV);
    __syncthreads();
    for (int idx = F.tid; idx < 256 * 16; idx += NWAVES * 64) { const int row = idx >> 4, ch = idx & 15; const size_t g = ((size_t)b * MEML + row) * 512 + hc * CD + ch * 8;
        *(LAS v4u*)(lds + row * CR_LD + ch * 16) = *(const GAS v4u*)(MK + g); *(LAS v4u*)(lds + CR_VOFF + row * CR_LD + ch * 16) = *(const GAS v4u*)(MV + g); }
    __syncthreads();
    const bf16* QC = (const bf16*)(F.ws + WS_QC); const bf16* GC = (const bf16*)(F.ws + WS_GC); bf16* CAT = (bf16*)(F.ws + WS_CAT);
#pragma unroll 1
    for (int qi = 0; qi < 4; ++qi) {
        const size_t qrow = (size_t)b * SEQ + (qb0 + qi) * 128 + 16 * F.wave + ql;
        bf16x8 qf[4];
#pragma unroll
        for (int ks = 0; ks < 4; ++ks) qf[ks] = *(const GAS bf16x8*)(QC + qrow * 512 + hc * CD + 32 * ks + 8 * g4);
        f32x4 sc[16];
#pragma unroll
        for (int t = 0; t < 16; ++t) { sc[t] = (f32x4){0.f, 0.f, 0.f, 0.f};
#pragma unroll
            for (int ks = 0; ks < 4; ++ks) sc[t] = MFMA16(frag_row(lds, CR_LD, 16 * t, 32 * ks, lane), qf[ks], sc[t]); }
        float m = -__builtin_inff();
#pragma unroll
        for (int t = 0; t < 16; ++t) m = fmaxf(m, fmaxf(fmaxf(sc[t][0], sc[t][1]), fmaxf(sc[t][2], sc[t][3])));
        m = fmaxf(m, __shfl_xor(m, 16)); m = fmaxf(m, __shfl_xor(m, 32));
        float l = 0.f;
#pragma unroll
        for (int t = 0; t < 16; ++t)
#pragma unroll
            for (int e = 0; e < 4; ++e) { const float p = fast_exp2(sc[t][e] - m); sc[t][e] = p; l += p; }
        l += __shfl_xor(l, 16); l += __shfl_xor(l, 32);
        f32x4 o[8];
#pragma unroll
        for (int dt = 0; dt < 8; ++dt) o[dt] = (f32x4){0.f, 0.f, 0.f, 0.f};
#pragma unroll
        for (int pr = 0; pr < 8; ++pr) { const bf16x8 pf = pack8(sc[2 * pr], sc[2 * pr + 1]);
#pragma unroll
            for (int dt = 0; dt < 8; ++dt) o[dt] = MFMA16(frag_tr2(lds + CR_VOFF, CR_LD, 32 * pr, 32 * pr + 16, 16 * dt, lane), pf, o[dt]); }
        const float il = 1.0f / l;
#pragma unroll
        for (int dt = 0; dt < 8; ++dt) { const v2u gv = *(const GAS v2u*)(GC + qrow * 512 + hc * CD + 16 * dt + 4 * g4);
            const float g0 = __uint_as_float(gv.x << 16), g1 = __uint_as_float(gv.x & 0xffff0000u), g2 = __uint_as_float(gv.y << 16), g3 = __uint_as_float(gv.y & 0xffff0000u);
            v2u w; w.x = pg8::cvt_pk_bf16(o[dt][0] * il * g0, o[dt][1] * il * g1); w.y = pg8::cvt_pk_bf16(o[dt][2] * il * g2, o[dt][3] * il * g3);
            *(GAS v2u*)(CAT + qrow * 2048 + 1536 + hc * CD + 16 * dt + 4 * g4) = w; }
    }
}

__device__ __forceinline__ f32x4 conv_sample4(const Frame& F, int i, int ch) {
    f32x4 y = *(const GAS f32x4*)(F.convb + ch);
#pragma unroll
    for (int t = 0; t < 3; ++t) y += *(const GAS f32x4*)(F.sconv + ((size_t)i * 3 + t) * CONVD + ch) * *(const GAS f32x4*)(F.convw + t * CONVD + ch);
    y += *(const GAS f32x4*)(F.out + O_CVS + ((size_t)i * 3 + 2) * CONVD + ch) * *(const GAS f32x4*)(F.convw + 3 * CONVD + ch);
    return silu4(y);
}
__device__ __forceinline__ void smp_ssd_item(Frame& F, int item) {
    const int i = item >> 4, h = item & 15, g = h >> 2, lane = F.lane, half = lane >> 5, l32 = lane & 31;
    const float dt = ((const float*)(F.ws + WS_DT))[((size_t)MP + i) * 16 + h];
    const float dA = __expf(-dt * __expf(F.alog[h]));
    const float dsk = F.dskip[h];
    const f32x4 xv4 = conv_sample4(F, i, h * 64 + (lane & ~3)); const float xv = (lane & 3) == 0 ? xv4.x : (lane & 3) == 1 ? xv4.y : (lane & 3) == 2 ? xv4.z : xv4.w;
    const f32x4 Bv = conv_sample4(F, i, 1024 + g * 128 + 4 * l32), Cv = conv_sample4(F, i, 1536 + g * 128 + 4 * l32);
    const float* S0 = F.sssm + ((size_t)i * NHS + h) * (PH * NST); float* S1 = F.out + O_SSS + ((size_t)i * NHS + h) * (PH * NST);
    float yacc = 0.f;
#pragma unroll 4
    for (int ps = 0; ps < 32; ++ps) {
        const int p = 2 * ps + half; const float xp = __shfl(xv, p) * dt;
        f32x4 s = *(const GAS f32x4*)(S0 + (size_t)p * NST + 4 * l32);
        s = s * dA + Bv * xp;
        *(GAS f32x4*)(S1 + (size_t)p * NST + 4 * l32) = s;
        float d = (s.x * Cv.x + s.y * Cv.y) + (s.z * Cv.z + s.w * Cv.w);
#pragma unroll
        for (int o = 1; o < 32; o <<= 1) d += __shfl_xor(d, o);
        const float d0 = __shfl(d, 0), d1 = __shfl(d, 32);
        if (lane == 2 * ps) yacc = d0; if (lane == 2 * ps + 1) yacc = d1;
    }
    ((float*)(F.ws + WS_SMP))[(size_t)i * 1024 + h * 64 + lane] = yacc + xv * dsk;
}
__device__ __forceinline__ void smp_att_item(Frame& F, int item) {
    const int i = item >> 3, h = item & 7, lane = F.lane, slot = lane >> 4, dl = lane & 15;
    const v2u qv = *(const GAS v2u*)((const bf16*)(F.ws + WS_Q) + ((size_t)MP + i) * AW + h * AD + 4 * dl);
    const f32x4 q = {__uint_as_float(qv.x << 16), __uint_as_float(qv.x & 0xffff0000u), __uint_as_float(qv.y << 16), __uint_as_float(qv.y & 0xffff0000u)};
    const float* kc = F.cwk + ((size_t)i * WBUF * AH + h) * AD + 4 * dl; const float* vc = F.cwv + ((size_t)i * WBUF * AH + h) * AD + 4 * dl;
    const float* kn = F.out + O_WKS + (size_t)i * AW + h * AD + 4 * dl; const float* vn = F.out + O_WVS + (size_t)i * AW + h * AD + 4 * dl;
    float m = -__builtin_inff(), l = 0.f; f32x4 acc = {0.f, 0.f, 0.f, 0.f};
#pragma unroll 1
    for (int di = 0; di < 3; ++di) {
        const int dil = di == 0 ? 1 : (di == 1 ? 4 : 16);
#pragma unroll 3
        for (int ps = 0; ps < 33; ++ps) {
            const int j = 4 * ps + slot; const bool valid = j < 129;
            const int row = valid ? WBUF - dil * j : 0;
            const float* kp = kc + (size_t)row * (AH * AD); const float* vp = vc + (size_t)row * (AH * AD);
            if (j == 0) { kp = kn; vp = vn; }
            const f32x4 kv = *(const GAS f32x4*)kp, vv = *(const GAS f32x4*)vp;
            float s = (q.x * kv.x + q.y * kv.y) + (q.z * kv.z + q.w * kv.w);
#pragma unroll
            for (int o = 1; o < 16; o <<= 1) s += __shfl_xor(s, o);
            if (!valid) s = -__builtin_inff();
            const float mn = fmaxf(m, s);
            if (mn > -__builtin_inff()) { const float al = fast_exp2(m - mn), p = fast_exp2(s - mn); l = l * al + p; acc = acc * al + vv * p; m = mn; }
        }
    }
    float M = fmaxf(m, __shfl_xor(m, 16)); M = fmaxf(M, __shfl_xor(M, 32));
    const float sc = fast_exp2(m - M); l *= sc; acc = acc * sc;
    l += __shfl_xor(l, 16); l += __shfl_xor(l, 32);
#pragma unroll
    for (int e = 0; e < 4; ++e) { float a = acc[e]; a += __shfl_xor(a, 16); a += __shfl_xor(a, 32); acc[e] = a; }
    if (slot == 0) *(GAS f32x4*)((float*)(F.ws + WS_SMP) + 128 * 1024 + (size_t)i * AW + h * AD + 4 * dl) = acc * (1.0f / l);
}
__device__ __forceinline__ void smp_cross_item(Frame& F, int item) {
    const int i = item >> 2, hc = item & 3, lane = F.lane, slot = lane >> 5, dl = lane & 31;
    const v2u qv = *(const GAS v2u*)((const bf16*)(F.ws + WS_QC) + ((size_t)MP + i) * 512 + hc * CD + 4 * dl);
    const f32x4 q = {__uint_as_float(qv.x << 16), __uint_as_float(qv.x & 0xffff0000u), __uint_as_float(qv.y << 16), __uint_as_float(qv.y & 0xffff0000u)};
    const float* kc = F.cmk + ((size_t)i * MEML * CH_ + hc) * CD + 4 * dl; const float* vc = F.cmv + ((size_t)i * MEML * CH_ + hc) * CD + 4 * dl;
    float m = -__builtin_inff(), l = 0.f; f32x4 acc = {0.f, 0.f, 0.f, 0.f};
#pragma unroll 4
    for (int ps = 0; ps < 128; ++ps) {
        const int row = 2 * ps + slot;
        const f32x4 kv = *(const GAS f32x4*)(kc + (size_t)row * (CH_ * CD)), vv = *(const GAS f32x4*)(vc + (size_t)row * (CH_ * CD));
        float s = (q.x * kv.x + q.y * kv.y) + (q.z * kv.z + q.w * kv.w);
#pragma unroll
        for (int o = 1; o < 32; o <<= 1) s += __shfl_xor(s, o);
        const float mn = fmaxf(m, s); const float al = fast_exp2(m - mn), p = fast_exp2(s - mn); l = l * al + p; acc = acc * al + vv * p; m = mn;
    }
    const float M = fmaxf(m, __shfl_xor(m, 32));
    const float sc = fast_exp2(m - M); l *= sc; acc = acc * sc;
    l += __shfl_xor(l, 32);
#pragma unroll
    for (int e = 0; e < 4; ++e) acc[e] += __shfl_xor(acc[e], 32);
    if (slot == 0) *(GAS f32x4*)((float*)(F.ws + WS_SMP) + 128 * 1024 + 128 * 512 + (size_t)i * 512 + hc * CD + 4 * dl) = acc * (1.0f / l);
}

constexpr int P4_C = 0, P4_B = 128 * SB_LD, P4_X = 2 * 128 * SB_LD, P4_CS = P4_X + 128 * SX_LD, P4_DT = P4_CS + 2048, P4_END = P4_DT + 2048;
static_assert(P4_END <= SCR_BYTES, "P4 LDS");
__device__ __forceinline__ void ssd_out_unit(Frame& F, int u) {
    const int b = u >> 7, c = (u >> 2) & 31, g = u & 3;
    int lane_ = F.lane; asm volatile("" : "+v"(lane_));
    LAS unsigned char* lds = F.lds; const int lane = lane_, wave = F.wave, g4 = lane >> 4, ql = lane & 15;
    LAS float* csT = (LAS float*)(lds + P4_CS); LAS float* dtT = (LAS float*)(lds + P4_DT);
    const int cg = F.tid & 63, seg = F.tid >> 6;
    const int xch = cg < 32 ? 256 * g + 8 * cg : (cg < 48 ? 1024 + 128 * g + 8 * (cg - 32) : 1536 + 128 * g + 8 * (cg - 48));
    v4u raw[19]; ConvW cw; conv_load(F, b, c, 16 * seg, xch, raw, cw);
    const float csv = ((const float*)(F.ws + WS_CSUM))[(((size_t)b * NCH + c) * NHS + 4 * g + (F.tid >> 7)) * LCH + (F.tid & 127)];
    const float dtv = ((const float*)(F.ws + WS_DT))[((size_t)b * SEQ + c * LCH + (F.tid & 127)) * 16 + 4 * g + (F.tid >> 7)];
    const bf16* SP = (const bf16*)(F.ws + WS_SPREV) + (((size_t)b * NCH + c) * NHS + 4 * g) * (PH * NST);
    v4u spv[4];
#pragma unroll
    for (int k = 0; k < 4; ++k) spv[k] = *(const GAS v4u*)(SP + (size_t)(F.tid + 512 * k) * 8);
    __syncthreads();
    csT[F.tid] = csv; dtT[F.tid] = dtv;
    { LAS unsigned char* dst = cg < 32 ? lds + P4_X + cg * 16 : (cg < 48 ? lds + P4_B + (cg - 32) * 16 : lds + P4_C + (cg - 48) * 16);
      const int ld = cg < 32 ? SX_LD : SB_LD;
      conv_compute(16 * seg, raw, cw, [&](int l, float (&y)[8]) { st8_lds(dst + l * ld, y); }); }
    __syncthreads();
    bf16x8 cf[4];
#pragma unroll
    for (int ks = 0; ks < 4; ++ks) cf[ks] = frag_row(lds + P4_C, SB_LD, 16 * wave, 32 * ks, lane);
    f32x4 cb[8];
#pragma unroll
    for (int st = 0; st < 8; ++st) { cb[st] = (f32x4){0.f, 0.f, 0.f, 0.f};
        if (st <= wave) {
#pragma unroll
            for (int ks = 0; ks < 4; ++ks) cb[st] = MFMA16(frag_row(lds + P4_B, SB_LD, 16 * st, 32 * ks, lane), cf[ks], cb[st]); } }
    const int lrow = 16 * wave + ql;
#pragma unroll
    for (int hp = 0; hp < 2; ++hp) {
        f32x4 y[2][4];
        __syncthreads();
#pragma unroll
        for (int k = 0; k < 4; ++k) { const int chunk = F.tid + 512 * k;
            *(LAS v4u*)(lds + P4_B + (chunk >> 4) * SB_LD + (chunk & 15) * 16) = spv[k]; }
        if (hp == 0) {
#pragma unroll
            for (int k = 0; k < 4; ++k) spv[k] = *(const GAS v4u*)(SP + (size_t)(F.tid + 512 * (4 + k)) * 8); }
        __syncthreads();
#pragma unroll
        for (int h2 = 0; h2 < 2; ++h2) {
            const int hh = 2 * hp + h2;
            const float csl = csT[hh * 128 + lrow];
#pragma unroll
            for (int pt = 0; pt < 4; ++pt) { f32x4 a = {0.f, 0.f, 0.f, 0.f};
#pragma unroll
                for (int ks = 0; ks < 4; ++ks) a = MFMA16(frag_row(lds + P4_B, SB_LD, 64 * h2 + 16 * pt, 32 * ks, lane), cf[ks], a);
                y[h2][pt] = a * __expf(csl); }
#pragma unroll
            for (int pr = 0; pr < 4; ++pr) {
                if (2 * pr <= wave) {
                    f32x4 m0, m1;
                    { const int s0 = 32 * pr + 4 * g4; const f32x4 css = *(const LAS f32x4*)(csT + hh * 128 + s0), dts = *(const LAS f32x4*)(dtT + hh * 128 + s0);
#pragma unroll
                      for (int e = 0; e < 4; ++e) m0[e] = (s0 + e <= lrow) ? cb[2 * pr][e] * __expf(csl - css[e]) * dts[e] : 0.f; }
                    { const int s0 = 32 * pr + 16 + 4 * g4; const f32x4 css = *(const LAS f32x4*)(csT + hh * 128 + s0), dts = *(const LAS f32x4*)(dtT + hh * 128 + s0);
#pragma unroll
                      for (int e = 0; e < 4; ++e) m1[e] = (s0 + e <= lrow) ? cb[2 * pr + 1][e] * __expf(csl - css[e]) * dts[e] : 0.f; }
                    const bf16x8 mf = pack8(m0, m1);
#pragma unroll
                    for (int pt = 0; pt < 4; ++pt) y[h2][pt] = MFMA16(frag_tr2(lds + P4_X, SX_LD, 32 * pr, 32 * pr + 16, 64 * hh + 16 * pt, lane), mf, y[h2][pt]);
                }
            }
            const float dsk = F.dskip[4 * g + hh];
#pragma unroll
            for (int pt = 0; pt < 4; ++pt) { const v2u xv = *(const LAS v2u*)(lds + P4_X + lrow * SX_LD + (64 * hh + 16 * pt + 4 * g4) * 2);
                y[h2][pt][0] += dsk * __uint_as_float(xv.x << 16); y[h2][pt][1] += dsk * __uint_as_float(xv.x & 0xffff0000u);
                y[h2][pt][2] += dsk * __uint_as_float(xv.y << 16); y[h2][pt][3] += dsk * __uint_as_float(xv.y & 0xffff0000u); }
        }
        if (hp == 1) __syncthreads();
#pragma unroll
        for (int h2 = 0; h2 < 2; ++h2)
#pragma unroll
            for (int pt = 0; pt < 4; ++pt) { v2u w; w.x = pg8::cvt_pk_bf16(y[h2][pt][0], y[h2][pt][1]); w.y = pg8::cvt_pk_bf16(y[h2][pt][2], y[h2][pt][3]);
                *(LAS v2u*)(lds + (hp == 0 ? P4_C : P4_B) + lrow * SB_LD + (64 * h2 + 16 * pt + 4 * g4) * 2) = w; }
    }
    const bf16* SZ = (const bf16*)(F.ws + WS_SZ); bf16* CAT = (bf16*)(F.ws + WS_CAT);
    v2u zr[16];
    asm volatile("" ::: "memory");
#pragma unroll
    for (int i = 0; i < 16; ++i) zr[i] = *(const GAS v2u*)(SZ + ((size_t)b * SEQ + c * LCH + 16 * wave + i) * DM + 256 * g + 4 * lane);
    const f32x4 gain = *(const GAS f32x4*)(F.ssdg + 256 * g + 4 * lane);
#pragma unroll
    for (int i = 0; i < 16; ++i) {
        const int l = 16 * wave + i; const size_t grow = (size_t)b * SEQ + c * LCH + l;
        const v2u yv = *(const LAS v2u*)(lds + (lane < 32 ? P4_C : P4_B) + l * SB_LD + (lane & 31) * 8); const v2u zv = zr[i];
        const float v0 = __uint_as_float(yv.x << 16) * __uint_as_float(zv.x << 16), v1 = __uint_as_float(yv.x & 0xffff0000u) * __uint_as_float(zv.x & 0xffff0000u);
        const float v2 = __uint_as_float(yv.y << 16) * __uint_as_float(zv.y << 16), v3 = __uint_as_float(yv.y & 0xffff0000u) * __uint_as_float(zv.y & 0xffff0000u);
        const float ss = wave_sum((v0 * v0 + v1 * v1) + (v2 * v2 + v3 * v3));
        const float rs = 1.0f / sqrtf(ss * (1.0f / 256.0f) + EPS);
        v2u w; w.x = pg8::cvt_pk_bf16(v0 * rs * gain.x, v1 * rs * gain.y); w.y = pg8::cvt_pk_bf16(v2 * rs * gain.z, v3 * rs * gain.w);
        *(GAS v2u*)(CAT + grow * 2048 + 256 * g + 4 * lane) = w;
    }
}
__device__ __forceinline__ void combine_row(Frame& F, int row) {
    const int lane = F.lane, hh = lane >> 3;
    const bf16* OP = (const bf16*)(F.ws + WS_OPART); const float* ML = (const float*)(F.ws + WS_ML);
    float m[3], l[3]; v4u o[3];
#pragma unroll
    for (int di = 0; di < 3; ++di) { const f32x2 ml = *(const GAS f32x2*)(ML + (((size_t)di * MP + row) * AH + hh) * 2); m[di] = ml.x; l[di] = ml.y; o[di] = *(const GAS v4u*)(OP + ((size_t)di * MP + row) * AW + 8 * lane); }
    const v4u gv = *(const GAS v4u*)((const bf16*)(F.ws + WS_GA) + (size_t)row * AW + 8 * lane);
    const float M = fmaxf(m[0], fmaxf(m[1], m[2]));
    float wgt[3], den = 0.f;
#pragma unroll
    for (int di = 0; di < 3; ++di) { wgt[di] = fast_exp2(m[di] - M) * l[di]; den += wgt[di]; }
    const float id = 1.0f / den; float r[8];
#pragma unroll
    for (int e = 0; e < 8; ++e) { float a = 0.f;
#pragma unroll
        for (int di = 0; di < 3; ++di) { const unsigned x = o[di][e >> 1]; a += wgt[di] * ((e & 1) ? __uint_as_float(x & 0xffff0000u) : __uint_as_float(x << 16)); }
        const unsigned gx = gv[e >> 1]; r[e] = a * id * ((e & 1) ? __uint_as_float(gx & 0xffff0000u) : __uint_as_float(gx << 16)); }
    v4u w; w.x = pg8::cvt_pk_bf16(r[0], r[1]); w.y = pg8::cvt_pk_bf16(r[2], r[3]); w.z = pg8::cvt_pk_bf16(r[4], r[5]); w.w = pg8::cvt_pk_bf16(r[6], r[7]);
    *(GAS v4u*)((bf16*)(F.ws + WS_CAT) + (size_t)row * 2048 + 1024 + 8 * lane) = w;
}
__device__ __forceinline__ void smp_mix_row(Frame& F, int i) {
    const int lane = F.lane; const size_t row = (size_t)MP + i;
    const float* YS = (const float*)(F.ws + WS_SMP) + (size_t)i * 1024; const float* OA = (const float*)(F.ws + WS_SMP) + 128 * 1024 + (size_t)i * 512; const float* OC = OA + 128 * 512;
    const bf16* SZ = (const bf16*)(F.ws + WS_SZ) + row * DM; bf16* CAT = (bf16*)(F.ws + WS_CAT) + row * 2048;
#pragma unroll
    for (int g = 0; g < 4; ++g) {
        const f32x4 yv = *(const GAS f32x4*)(YS + 256 * g + 4 * lane); const v2u zv = *(const GAS v2u*)(SZ + 256 * g + 4 * lane);
        const float v0 = yv.x * __uint_as_float(zv.x << 16), v1 = yv.y * __uint_as_float(zv.x & 0xffff0000u), v2 = yv.z * __uint_as_float(zv.y << 16), v3 = yv.w * __uint_as_float(zv.y & 0xffff0000u);
        const float ss = wave_sum((v0 * v0 + v1 * v1) + (v2 * v2 + v3 * v3)); const float rs = 1.0f / sqrtf(ss * (1.0f / 256.0f) + EPS);
        const f32x4 gain = *(const GAS f32x4*)(F.ssdg + 256 * g + 4 * lane);
        v2u w; w.x = pg8::cvt_pk_bf16(v0 * rs * gain.x, v1 * rs * gain.y); w.y = pg8::cvt_pk_bf16(v2 * rs * gain.z, v3 * rs * gain.w);
        *(GAS v2u*)(CAT + 256 * g + 4 * lane) = w;
    }
#pragma unroll
    for (int k = 0; k < 2; ++k) {
        const float* O = (k == 0 ? OA : OC) + 8 * lane; const bf16* G = (const bf16*)(F.ws + (k == 0 ? WS_GA : WS_GC)) + row * 512 + 8 * lane;
        const f32x4 a = *(const GAS f32x4*)O, b2 = *(const GAS f32x4*)(O + 4); const v4u gv = *(const GAS v4u*)G;
        v4u w; w.x = pg8::cvt_pk_bf16(a.x * __uint_as_float(gv.x << 16), a.y * __uint_as_float(gv.x & 0xffff0000u)); w.y = pg8::cvt_pk_bf16(a.z * __uint_as_float(gv.y << 16), a.w * __uint_as_float(gv.y & 0xffff0000u));
        w.z = pg8::cvt_pk_bf16(b2.x * __uint_as_float(gv.z << 16), b2.y * __uint_as_float(gv.z & 0xffff0000u)); w.w = pg8::cvt_pk_bf16(b2.z * __uint_as_float(gv.w << 16), b2.w * __uint_as_float(gv.w & 0xffff0000u));
        *(GAS v4u*)(CAT + 1024 + 512 * k + 8 * lane) = w;
    }
}
struct Epi2 {
    static constexpr bool PERM = true, AFTER_DRAIN = false;
    const float* xp; const float* xs; float* out;
    __device__ __forceinline__ void operator()(const pg8::f32x4 (&acc)[2][2][4][2], const pg8::Unit& u, int wr, int wc, int fr, int fq) const {
        const int rbase = u.pm * 256 + wr * 64 + fr, cbase = u.pn * 256 + wc * 32 + 8 * fq;
        if (u.pm < 128) {
#pragma unroll
            for (int ai = 0; ai < 2; ++ai)
#pragma unroll
                for (int m = 0; m < 4; ++m) { const size_t off = (size_t)(rbase + ai * 128 + m * 16) * DM + cbase;
                    f32x4 r0[2], r1[2];
#pragma unroll
                    for (int bj = 0; bj < 2; ++bj) { r0[bj] = *(const GAS f32x4*)(xp + off + bj * 128); r1[bj] = *(const GAS f32x4*)(xp + off + bj * 128 + 4); }
#pragma unroll
                    for (int bj = 0; bj < 2; ++bj) st8_f32(out + O_YP + off + bj * 128, acc[ai][bj][m][0] + r0[bj], acc[ai][bj][m][1] + r1[bj]); }
        } else {
#pragma unroll
            for (int ai = 0; ai < 2; ++ai)
#pragma unroll
                for (int m = 0; m < 4; ++m) { const int row = rbase + ai * 128 + m * 16 - MP;
                    if (row < NS) { const size_t off = (size_t)row * DM + cbase;
#pragma unroll
                        for (int bj = 0; bj < 2; ++bj) st8_f32(out + O_YS + off + bj * 128, acc[ai][bj][m][0] + *(const GAS f32x4*)(xs + off + bj * 128), acc[ai][bj][m][1] + *(const GAS f32x4*)(xs + off + bj * 128 + 4)); } }
        }
    }
};
struct Sched2 {
    int G, c;
    __device__ __forceinline__ bool next(int i, pg8::Unit& u) const {
        constexpr int nM = MP / 256, nN = 4, nwg = nM * nN, q = nwg / 8, r = nwg % 8;
        const int L = i * G + c; if (L >= nwg) return false;
        const int xcd = L % 8, off = L / 8; const int wgid = (xcd < r ? xcd * (q + 1) : r * (q + 1) + (xcd - r) * q) + off;
        constexpr int nig = pg8::WGM * nN; const int gid = wgid / nig, fm = gid * pg8::WGM, gsz = (nM - fm) < pg8::WGM ? (nM - fm) : pg8::WGM;
        u.pm = fm + ((wgid % nig) % gsz); u.pn = (wgid % nig) / gsz; return true;
    }
    __device__ __forceinline__ void a_ready(const pg8::Unit&) const {}
    __device__ __forceinline__ void done(const pg8::Unit&) const {}
};
__device__ __forceinline__ void smp_outproj_item(Frame& F, int item) {
    const int rt = item >> 6, ct = item & 63, lane = F.lane, g4 = lane >> 4, ql = lane & 15;
    const bf16* A = (const bf16*)(F.ws + WS_CAT) + ((size_t)MP + 16 * rt + ql) * 2048 + 8 * g4; const bf16* B = (const bf16*)(F.ws + WS_WOT) + ((size_t)16 * ct + ql) * 2048 + 8 * g4;
    f32x4 acc = {0.f, 0.f, 0.f, 0.f};
#pragma unroll 16
    for (int ks = 0; ks < 64; ++ks) acc = MFMA16(*(const GAS bf16x8*)(A + 32 * ks), *(const GAS bf16x8*)(B + 32 * ks), acc);
#pragma unroll
    for (int e = 0; e < 4; ++e) { const size_t off = (size_t)(16 * rt + 4 * g4 + e) * DM + 16 * ct + ql; F.out[O_YS + off] = acc[e] + F.xs[off]; }
}
__device__ __forceinline__ void final_norm_row(Frame& F, float* rowp) {
    GAS f32x4* xr = (GAS f32x4*)rowp + F.lane; f32x4 v[4]; float s = 0.f;
#pragma unroll
    for (int j = 0; j < 4; ++j) { v[j] = xr[64 * j]; s += (v[j].x * v[j].x + v[j].y * v[j].y) + (v[j].z * v[j].z + v[j].w * v[j].w); }
    const float rs = 1.0f / sqrtf(wave_sum(s) * (1.0f / DM) + EPS);
#pragma unroll
    for (int j = 0; j < 4; ++j) { const f32x4 gn = *((const GAS f32x4*)F.fng + F.lane + 64 * j); xr[64 * j] = v[j] * rs * gn; }
}

#ifndef MK_N_LAUNCHES
#define MK_N_LAUNCHES 1
#endif
#define PROBE_N 2
#define PROBE_MASK 63
constexpr int N_PHASES = 7;
struct Args { const float *xp, *xs, *mem, *cwk, *cwv, *cmk, *cmv, *sconv, *sssm, *pos, *lng, *win, *convw, *convb, *dtb, *alog, *dskip, *ssdg, *memg, *wmem, *wout, *fng; float* out; unsigned char* ws; int ph_lo, ph_hi, li, mask; };
__global__ void __launch_bounds__(NWAVES * 64, 2) mk_fwd(Args args) {
    extern __shared__ __attribute__((aligned(16))) unsigned char lds[];
    Frame F;
    F.lds = (LAS unsigned char*)lds;
    F.MISC = (volatile LAS unsigned*)(F.lds + MISC_OFF);
    F.tid = threadIdx.x; F.lane = F.tid & 63; F.wave = __builtin_amdgcn_readfirstlane(F.tid >> 6);
    F.G = gridDim.x; { const int bx = blockIdx.x; F.vcu = (F.G % 8 == 0) ? (bx % 8) * (F.G / 8) + bx / 8 : bx; }
    F.ws = args.ws; F.out = args.out; F.ctl = (gu32*)(args.ws + WS_CTL);
    F.xp = args.xp;
    F.xs = args.xs;
    F.mem = args.mem;
    F.cwk = args.cwk;
    F.cwv = args.cwv;
    F.cmk = args.cmk;
    F.cmv = args.cmv;
    F.sconv = args.sconv;
    F.sssm = args.sssm;
    F.pos = args.pos;
    F.lng = args.lng;
    F.win = args.win;
    F.convw = args.convw;
    F.convb = args.convb;
    F.dtb = args.dtb;
    F.alog = args.alog;
    F.dskip = args.dskip;
    F.ssdg = args.ssdg;
    F.memg = args.memg;
    F.wmem = args.wmem;
    F.wout = args.wout;
    F.fng = args.fng;
    if (F.tid < 32) F.MISC[F.tid] = 0u;
    __syncthreads();
    XcdBarrier bar = xcd_barrier_post((unsigned*)(F.ctl + CW_BAR) + args.li * XCD_BAR_WORDS, F.MISC + 8);
    const int lo = args.ph_lo, hi = args.ph_hi;
#ifdef PH_ONLY
#define IN(k) ((k) == PH_ONLY)
#else
#define IN(k) (lo <= (k) && (k) < hi)
#endif
#define SEAM(k) do { if (IN(k) && IN((k) + 1)) xcd_barrier(bar); } while (0)

    if (IN(0)) { p0_prologue(F); __syncthreads(); }
    SEAM(0);
    if (IN(1)) {
        pg8::Gemm g{(const pg8::bf16_t*)(F.ws + WS_XN), (const pg8::bf16_t*)(F.ws + WS_WT), XNR, NTOT, DM};
        Sched1 S{F.G, (int)blockIdx.x};
        Epi1 E{(const float*)(F.ws + WS_RSTD), (const float*)(F.ws + WS_ROPE), F.out, F.ws};
        pg8::gemm_phase<Epi1, Sched1, true, true>(F.lds, g, S, E);
    }
    SEAM(1);
    if (IN(2)) {
        const int P2_PARTS = args.mask;
        if (P2_PARTS & 1) for (int u = F.vcu; u < NB * NCH * NGRP; u += F.G) ssd_state_unit(F, u);
        if (P2_PARTS & 2) for (int u = F.vcu; u < NB * AH * 48; u += F.G) attn_unit(F, u);
        if (P2_PARTS & 4) for (int u = F.vcu; u < 256; u += F.G) cross_group(F, u);
        const int gw = F.vcu * NWAVES + F.wave, NGW = F.G * NWAVES;
        if (P2_PARTS & 8) for (int it = gw; it < NS * NHS; it += NGW) smp_ssd_item(F, it);
        if (P2_PARTS & 16) for (int it = gw; it < NS * AH; it += NGW) smp_att_item(F, it);
        if (P2_PARTS & 32) for (int it = gw; it < NS * CH_; it += NGW) smp_cross_item(F, it);
        { const int gt = F.vcu * (NWAVES * 64) + F.tid, NGT = F.G * NWAVES * 64;
          for (int it = gt; it < NS * 2 * CONVD / 4; it += NGT) { const int i = it / (2 * CONVD / 4), rem = it % (2 * CONVD / 4);
              *(GAS f32x4*)(F.out + O_CVS + (size_t)i * 3 * CONVD + 4 * rem) = *(const GAS f32x4*)(F.sconv + (size_t)i * 3 * CONVD + CONVD + 4 * rem); } }
        __syncthreads();
    }
    SEAM(2);
    if (IN(3)) p3_recurrence(F);
    SEAM(3);
    if (IN(4)) {
        if (args.mask & 1) for (int u = F.vcu; u < NB * NCH * NGRP; u += F.G) ssd_out_unit(F, u);
        const int gw = F.vcu * NWAVES + F.wave, NGW = F.G * NWAVES;
        if (args.mask & 2) for (int it = gw; it < MP; it += NGW) combine_row(F, it);
        if (args.mask & 4) for (int it = gw; it < NS; it += NGW) smp_mix_row(F, it);
        __syncthreads();
    }
    SEAM(4);
    if (IN(5)) {
        pg8::Gemm g{(const pg8::bf16_t*)(F.ws + WS_CAT), (const pg8::bf16_t*)(F.ws + WS_WOT), RTOT, DM, 2048};
        Sched2 S{F.G, (int)blockIdx.x};
        Epi2 E{F.xp, F.xs, F.out};
        pg8::gemm_phase<Epi2, Sched2, true, true>(F.lds, g, S, E);
        for (int it = F.vcu * NWAVES + F.wave; it < 512; it += F.G * NWAVES) smp_outproj_item(F, it);
    }
    SEAM(5);
    if (IN(6)) {
        const int gw = F.vcu * NWAVES + F.wave, NGW = F.G * NWAVES;
        for (int it = gw; it < MP + NS; it += NGW) final_norm_row(F, it < MP ? F.out + O_YP + (size_t)it * DM : F.out + O_YS + (size_t)(it - MP) * DM);
    }
#undef IN
#undef SEAM
}

extern "C" void kernel_launch(void* const* d_in, const int* in_sizes, int n_in, void* d_out, int out_size, void* d_ws, size_t ws_size, hipStream_t stream) {
    static int grid = 0;
    if (grid == 0) {
        if (n_in != N_INPUTS || (size_t)out_size != O_END || ws_size < WS_END) { fprintf(stderr, "kernel_launch: unexpected shapes (n_in %d, out %d, ws %zu); nothing launched\n", n_in, out_size, ws_size); grid = -1; return; }
        int dev = 0, cus = 0, per_cu = 0;
        if (hipGetDevice(&dev) != hipSuccess || hipDeviceGetAttribute(&cus, hipDeviceAttributeMultiprocessorCount, dev) != hipSuccess) { grid = -1; return; }
        if (hipFuncSetAttribute((const void*)mk_fwd, hipFuncAttributeMaxDynamicSharedMemorySize, LDS_BYTES) != hipSuccess) { fprintf(stderr, "kernel_launch: hipFuncSetAttribute failed\n"); grid = -1; return; }
        if (hipOccupancyMaxActiveBlocksPerMultiprocessor(&per_cu, (const void*)mk_fwd, NWAVES * 64, LDS_BYTES) != hipSuccess || per_cu < 1) { fprintf(stderr, "kernel_launch: occupancy query reports %d blocks per CU\n", per_cu); }
        (void)hipGetLastError();
        grid = cus;
    }
    if (grid < 0) return;
    if (hipMemsetAsync((char*)d_ws + WS_CTL, 0, CTL_ZERO_BYTES, stream) != hipSuccess) return;
    Args a{};
    a.xp = (const float*)d_in[I_XP];
    a.xs = (const float*)d_in[I_XS];
    a.mem = (const float*)d_in[I_MEM];
    a.cwk = (const float*)d_in[I_CWK];
    a.cwv = (const float*)d_in[I_CWV];
    a.cmk = (const float*)d_in[I_CMK];
    a.cmv = (const float*)d_in[I_CMV];
    a.sconv = (const float*)d_in[I_SCONV];
    a.sssm = (const float*)d_in[I_SSSM];
    a.pos = (const float*)d_in[I_POS];
    a.lng = (const float*)d_in[I_LNG];
    a.win = (const float*)d_in[I_WIN];
    a.convw = (const float*)d_in[I_CONVW];
    a.convb = (const float*)d_in[I_CONVB];
    a.dtb = (const float*)d_in[I_DTB];
    a.alog = (const float*)d_in[I_ALOG];
    a.dskip = (const float*)d_in[I_DSKIP];
    a.ssdg = (const float*)d_in[I_SSDG];
    a.memg = (const float*)d_in[I_MEMG];
    a.wmem = (const float*)d_in[I_WMEM];
    a.wout = (const float*)d_in[I_WOUT];
    a.fng = (const float*)d_in[I_FNG];
    a.out = (float*)d_out; a.ws = (unsigned char*)d_ws;
    a.mask = 63;
#if defined(PROBE_PH)
    for (int li = 0; li < N_PHASES; ++li) { a.ph_lo = li; a.ph_hi = li + 1; a.li = li; a.mask = 63; hipLaunchKernelGGL(mk_fwd, dim3(grid), dim3(NWAVES * 64), LDS_BYTES, stream, a);
        if (li == PROBE_PH) for (int r = 0; r < PROBE_N; ++r) { a.mask = PROBE_MASK; hipLaunchKernelGGL(mk_fwd, dim3(grid), dim3(NWAVES * 64), LDS_BYTES, stream, a); } }
#else
    if (MK_N_LAUNCHES == 1) { a.ph_lo = 0; a.ph_hi = N_PHASES; a.li = 0; hipLaunchKernelGGL(mk_fwd, dim3(grid), dim3(NWAVES * 64), LDS_BYTES, stream, a); }
    else for (int li = 0; li < N_PHASES; ++li) { a.ph_lo = li; a.ph_hi = li + 1; a.li = li; hipLaunchKernelGGL(mk_fwd, dim3(grid), dim3(NWAVES * 64), LDS_BYTES, stream, a); }
#endif
}
```
